# Optimizing an MI355X kernel written in HIP

```python
import math
import jax, jax.numpy as jnp
from jax import lax
import numpy as np

D_MODEL = 1024
BATCH = 8
SEQ = 4096
DEPTH = 1

N_META = 16
D_MIX = D_MODEL
HEAD_DIM = 64
D_FOX = D_MIX // 2
D_RWKV = D_MIX - D_FOX
H_FOX = D_FOX // HEAD_DIM
H_RWKV = D_RWKV // HEAD_DIM
RANK_W = 64
RANK_A = 64
Q_BLOCK = 128
NORM_EPS = 1e-6
GN_EPS = 64e-5
NEG_INF = -1e30

FOX_SIZES = (D_FOX, D_FOX, D_FOX, H_FOX, D_FOX)
RWKV_SIZES = (D_RWKV, D_RWKV, D_RWKV, RANK_W, RANK_A, D_RWKV)
D_FOX_IN = sum(FOX_SIZES)
D_RWKV_IN = sum(RWKV_SIZES)
D_IN = D_FOX_IN + D_RWKV_IN
D_SHIFT = 3 * D_RWKV + RANK_W + RANK_A

kernel_name = "hymba_fox_rwkv7_hybrid_block"


def _split(p, sizes):
    offs = [int(o) for o in np.cumsum(sizes)[:-1]]
    return jnp.split(p, offs, axis=-1)


def rmsnorm(x, w):
    xf = x.astype(jnp.float32)
    y = xf * lax.rsqrt(jnp.mean(xf * xf, axis=-1, keepdims=True) + NORM_EPS)
    return (y * w.astype(jnp.float32)).astype(x.dtype)


def _heads(t, n_heads):
    b, l, _ = t.shape
    return t.reshape(b, l, n_heads, -1).transpose(0, 2, 1, 3)


def _fox_block(q, k, v, cq, ck, q_start):
    qb, kb = q.shape[2], k.shape[2]
    s = jnp.einsum('bhqd,bhkd->bhqk', q, k).astype(jnp.float32) / math.sqrt(HEAD_DIM)
    s = s + cq[..., :, None] - ck[..., None, :]
    q_pos = q_start + jnp.arange(qb)
    k_pos = jnp.arange(kb)
    s = jnp.where(k_pos[None, :] <= q_pos[:, None], s, NEG_INF)
    p = jax.nn.softmax(s, axis=-1)
    return jnp.einsum('bhqk,bhkd->bhqd', p, v.astype(jnp.float32))


def fox_branch(p, b_f):
    b, l, _ = p.shape
    q, k, v, fl, z = _split(p, FOX_SIZES)
    q, k, v = _heads(q, H_FOX), _heads(k, H_FOX), _heads(v, H_FOX)
    log_f = jax.nn.log_sigmoid(fl.astype(jnp.float32) + b_f.astype(jnp.float32))
    c = jnp.cumsum(log_f, axis=1).transpose(0, 2, 1)
    n_real = l - N_META
    bounds = [(0, N_META)] + [(N_META + i * Q_BLOCK, min(N_META + (i + 1) * Q_BLOCK, l))
                              for i in range(-(-n_real // Q_BLOCK))]
    outs = [_fox_block(q[:, :, s0:s1], k[:, :, :s1], v[:, :, :s1], c[:, :, s0:s1], c[:, :, :s1], s0)
            for (s0, s1) in bounds]
    o = jnp.concatenate(outs, axis=2).transpose(0, 2, 1, 3).reshape(b, l, D_FOX)
    return (o * jax.nn.silu(z.astype(jnp.float32))).astype(p.dtype)


def _rwkv7_step(S, inp):
    r_t, w_t, k_t, v_t, a_t, b_t = inp
    sa = jnp.einsum('bhij,bhj->bhi', S, a_t)
    S = S * w_t[:, :, None, :] + sa[..., None] * b_t[:, :, None, :] + v_t[..., None] * k_t[:, :, None, :]
    y = jnp.einsum('bhij,bhj->bhi', S, r_t)
    return S, y


def rwkv_branch(p, mu, w0, w_up, a0, a_up, k_k, k_a, r_k, gn_w, gn_b):
    b, l, _ = p.shape
    f32 = jnp.float32
    ps, z = p[..., :D_SHIFT], p[..., D_SHIFT:]
    prev = jnp.pad(ps, ((0, 0), (1, 0), (0, 0)))[:, :-1]
    ps = (ps + mu * (prev - ps)).astype(f32)
    r, k, v, wd, ad = _split(ps, (D_RWKV, D_RWKV, D_RWKV, RANK_W, RANK_A))
    w = -jax.nn.softplus(-(w0.astype(f32) + jnp.tanh(wd) @ w_up.astype(f32))) - 0.5
    decay = jnp.exp(-jnp.exp(w))
    a = jax.nn.sigmoid(a0.astype(f32) + ad @ a_up.astype(f32))
    kk = (k * k_k.astype(f32)).reshape(b, l, H_RWKV, HEAD_DIM)
    kk = kk * lax.rsqrt(jnp.sum(kk * kk, axis=-1, keepdims=True) + 1e-12)
    k = k * (1.0 + (a - 1.0) * k_a.astype(f32))
    hd = lambda t: t.reshape(b, l, H_RWKV, HEAD_DIM)
    r, k, v, decay, a = hd(r), hd(k), hd(v), hd(decay), hd(a)
    a_vec, b_vec = -kk, kk * a
    tm = lambda t: jnp.moveaxis(t, 1, 0)
    S0 = jnp.zeros((b, H_RWKV, HEAD_DIM, HEAD_DIM), f32)
    _, y = lax.scan(_rwkv7_step, S0, (tm(r), tm(decay), tm(k), tm(v), tm(a_vec), tm(b_vec)))
    y = jnp.moveaxis(y, 0, 1)
    mean = jnp.mean(y, axis=-1, keepdims=True)
    var = jnp.mean(jnp.square(y - mean), axis=-1, keepdims=True)
    y = ((y - mean) * lax.rsqrt(var + GN_EPS)).reshape(b, l, D_RWKV)
    y = y * gn_w.astype(f32) + gn_b.astype(f32)
    bonus = jnp.sum(r * k * r_k.astype(f32), axis=-1, keepdims=True) * v
    y = y + bonus.reshape(b, l, D_RWKV)
    return (y * jax.nn.silu(z.astype(f32))).astype(p.dtype)


def setup_inputs(seed: int = 0) -> dict:
    key = jax.random.key(seed)
    ks = jax.random.split(key, 20)
    nrm = jax.random.normal
    x = nrm(ks[0], (BATCH, SEQ, D_MODEL), jnp.float32)
    meta = nrm(ks[1], (N_META, D_MODEL), jnp.float32)
    norm_w = 1.0 + 0.1 * nrm(ks[2], (DEPTH, D_MODEL), jnp.float32)
    w_in = nrm(ks[3], (DEPTH, D_MODEL, D_IN), jnp.float32) * D_MODEL ** -0.5
    b_f = jax.random.uniform(ks[4], (DEPTH, H_FOX), jnp.float32, 1.0, 5.0)
    mu_shift = jax.random.uniform(ks[5], (DEPTH, D_SHIFT), jnp.float32)
    w0 = jax.random.uniform(ks[6], (DEPTH, D_RWKV), jnp.float32, -7.0, -1.0)
    w_up = 0.5 * nrm(ks[7], (DEPTH, RANK_W, D_RWKV), jnp.float32) * RANK_W ** -0.5
    a0 = 0.5 * nrm(ks[8], (DEPTH, D_RWKV), jnp.float32)
    a_up = 0.5 * nrm(ks[9], (DEPTH, RANK_A, D_RWKV), jnp.float32) * RANK_A ** -0.5
    k_k = 0.85 + 0.05 * nrm(ks[10], (DEPTH, D_RWKV), jnp.float32)
    k_a = 1.0 + 0.05 * nrm(ks[11], (DEPTH, D_RWKV), jnp.float32)
    r_k = 0.1 * nrm(ks[12], (DEPTH, H_RWKV, HEAD_DIM), jnp.float32)
    gn_w = 1.0 + 0.1 * nrm(ks[13], (DEPTH, D_RWKV), jnp.float32)
    gn_b = 0.02 * nrm(ks[14], (DEPTH, D_RWKV), jnp.float32)
    w_out = nrm(ks[15], (DEPTH, D_MIX, D_MODEL), jnp.float32) * D_MIX ** -0.5
    final_norm_w = 1.0 + 0.1 * nrm(ks[16], (D_MODEL,), jnp.float32)
    return {"x": x, "meta": meta, "norm_w": norm_w, "w_in": w_in, "b_f": b_f,
            "mu_shift": mu_shift, "w0": w0, "w_up": w_up, "a0": a0, "a_up": a_up,
            "k_k": k_k, "k_a": k_a, "r_k": r_k, "gn_w": gn_w, "gn_b": gn_b,
            "w_out": w_out, "final_norm_w": final_norm_w}


def reference(x, meta, norm_w, w_in, b_f, mu_shift, w0, w_up, a0, a_up, k_k, k_a, r_k,
              gn_w, gn_b, w_out, final_norm_w):
    b = x.shape[0]
    h = jnp.concatenate([jnp.broadcast_to(meta[None].astype(x.dtype), (b, N_META, x.shape[-1])), x], axis=1)
    for l in range(DEPTH):
        u = rmsnorm(h, norm_w[l])
        p = u @ w_in[l]
        p_fox, p_rwkv = p[..., :D_FOX_IN], p[..., D_FOX_IN:]
        y_fox = fox_branch(p_fox, b_f[l])
        y_rwkv = rwkv_branch(p_rwkv, mu_shift[l], w0[l], w_up[l], a0[l], a_up[l],
                             k_k[l], k_a[l], r_k[l], gn_w[l], gn_b[l])
        h = h + jnp.concatenate([y_fox, y_rwkv], axis=-1) @ w_out[l]
    h = rmsnorm(h, final_norm_w)
    return h[:, N_META:]
```

```cpp
#include <hip/hip_runtime.h>
#include <hip/hip_cooperative_groups.h>
#include <cstdio>
#include <cstdint>
namespace cg = cooperative_groups;
namespace pg8 {
#define PG8_LAS __attribute__((address_space(3)))
typedef unsigned short bf16_t;
typedef short bf16x8 __attribute__((ext_vector_type(8)));
typedef float f32x4 __attribute__((ext_vector_type(4)));
typedef unsigned u32x4 __attribute__((ext_vector_type(4)));
constexpr int BM = 256, BK = 64, HALF = 128, HTB = HALF * BK * 2  , STAGE_BYTES = 8 * HTB, NXCD = 8, WGM = 8;

__host__ __device__ __forceinline__ int lds_byte(int r, int c) { const int st = (r >> 4) * 2 + (c >> 5), rr = r & 15, cc = c & 31, ob = rr * 64 + cc * 2; return st * 1024 + (ob ^ (((ob >> 9) & 1) << 5)); }
__host__ __device__ __forceinline__ void stage_rc(int b, int& R, int& C) { const int st = b / 1024, sb = b % 1024, swz = sb ^ (((sb >> 9) & 1) << 5); R = (st >> 1) * 16 + swz / 64; C = (st & 1) * 32 + (swz % 64) / 2; }
__host__ __device__ __forceinline__ int perm32(int rho) { const int n = rho >> 4, i = rho & 15; return 8 * (i >> 2) + 4 * n + (i & 3); }

struct Unit { int pm, pn; };
struct Gemm { const bf16_t* A; const bf16_t* Bt; int M, N, K; };

struct StaticOrder {
    int nM, nN, nwg, G, c;
    __host__ __device__ void init(int M, int N, int G_, int c_) { nM = M / BM; nN = N / BM; nwg = nM * nN; G = G_; c = c_; }
    __host__ __device__ bool next(int i, Unit& u) const {
        const long L = (long)i * G + c; if (L >= nwg) return false;
        int wgid = (int)L; { const int q = nwg / NXCD, r = nwg % NXCD, xcd = wgid % NXCD, off = wgid / NXCD; wgid = (xcd < r ? xcd * (q + 1) : r * (q + 1) + (xcd - r) * q) + off; }
        const int nig = WGM * nN, gid = wgid / nig, fm = gid * WGM, gsz = (nM - fm) < WGM ? (nM - fm) : WGM;
        u.pm = fm + ((wgid % nig) % gsz); u.pn = (wgid % nig) / gsz; return true;
    }
    __device__ __forceinline__ void a_ready(const Unit&) const {}
    __device__ __forceinline__ void done(const Unit&) const {}
};

__device__ __forceinline__ unsigned cvt_pk_bf16(float lo, float hi) { unsigned r; asm volatile("v_cvt_pk_bf16_f32 %0, %1, %2" : "=v"(r) : "v"(lo), "v"(hi)); return r; }
typedef float f32x2 __attribute__((ext_vector_type(2)));
struct EpiBf16 {
    static constexpr bool PERM = true, AFTER_DRAIN = false;
    bf16_t* O; int ldc;
    __device__ __forceinline__ void operator()(const f32x4 (&acc)[2][2][4][2], const Unit& u, int wr, int wc, int fr, int fq) const {
        const int row0 = u.pm * BM + wr * 64 + fr; const int col0 = u.pn * BM + wc * 32 + 8 * fq;
#pragma unroll
        for (int ai = 0; ai < 2; ++ai)
#pragma unroll
            for (int m = 0; m < 4; ++m) { bf16_t* rowp = O + (size_t)(row0 + ai * HALF + m * 16) * ldc + col0;
#pragma unroll
                for (int bj = 0; bj < 2; ++bj) { const f32x4 v0 = acc[ai][bj][m][0], v1 = acc[ai][bj][m][1];
                    u32x4 w; w.x = cvt_pk_bf16(v0[0], v0[1]); w.y = cvt_pk_bf16(v0[2], v0[3]); w.z = cvt_pk_bf16(v1[0], v1[1]); w.w = cvt_pk_bf16(v1[2], v1[3]);
                    *(u32x4*)(rowp + bj * HALF) = w; } }
    }
};
struct EpiRes {
    static constexpr bool PERM = false, AFTER_DRAIN = false;
    const float* base; float* out; float* rowss; int ldc;
    __device__ __forceinline__ void operator()(const f32x4 (&acc)[2][2][4][2], const Unit& u, int wr, int wc, int fr, int fq) const {
        const int col0 = u.pn * BM + wc * 32 + 4 * fq;
#pragma unroll
        for (int ai = 0; ai < 2; ++ai)
#pragma unroll
            for (int m = 0; m < 4; ++m) { const int row = u.pm * BM + ai * HALF + wr * 64 + m * 16 + fr; const size_t off = (size_t)row * ldc + col0; float ss = 0.f;
#pragma unroll
                for (int bj = 0; bj < 2; ++bj)
#pragma unroll
                    for (int n = 0; n < 2; ++n) { const f32x4 bs = *(const f32x4*)(base + off + bj * HALF + n * 16); const f32x4 o = bs + acc[ai][bj][m][n];
                        ss += (o[0] * o[0] + o[1] * o[1]) + (o[2] * o[2] + o[3] * o[3]); *(f32x4*)(out + off + bj * HALF + n * 16) = o; }
                ss += __shfl_xor(ss, 16); ss += __shfl_xor(ss, 32);
                if (fq == 0) atomicAdd(rowss + row, ss); }
    }
};
struct EpiResNorm {
    static constexpr bool PERM = false, AFTER_DRAIN = false;
    const float* base; float* out; float* rowss; unsigned* cnt; const float* fw; int ldc;
    __device__ __forceinline__ void operator()(f32x4 (&acc)[2][2][4][2], const Unit& u, int wr, int wc, int fr, int fq) const {
        const int col0 = u.pn * BM + wc * 32 + 4 * fq;
#pragma unroll
        for (int ai = 0; ai < 2; ++ai)
#pragma unroll
            for (int m = 0; m < 4; ++m) { const int row = u.pm * BM + ai * HALF + wr * 64 + m * 16 + fr; const size_t off = (size_t)row * ldc + col0; float ss = 0.f;
#pragma unroll
                for (int bj = 0; bj < 2; ++bj)
#pragma unroll
                    for (int n = 0; n < 2; ++n) { const f32x4 bs = *(const f32x4*)(base + off + bj * HALF + n * 16); const f32x4 o = bs + acc[ai][bj][m][n]; acc[ai][bj][m][n] = o;
                        ss += (o[0] * o[0] + o[1] * o[1]) + (o[2] * o[2] + o[3] * o[3]); }
                ss += __shfl_xor(ss, 16); ss += __shfl_xor(ss, 32);
                if (fq == 0) atomicAdd(rowss + row, ss); }
        asm volatile("s_waitcnt vmcnt(0)" ::: "memory");
        unsigned* pc = cnt + 64 * u.pm;
        if (fr == 0 && fq == 0) __hip_atomic_fetch_add(pc, 1u, __ATOMIC_RELAXED, __HIP_MEMORY_SCOPE_AGENT);
        { unsigned sp = 0; while (__hip_atomic_load(pc, __ATOMIC_RELAXED, __HIP_MEMORY_SCOPE_AGENT) < 32u) { __builtin_amdgcn_s_sleep(2); if (++sp > (1u << 22)) break; } }
        asm volatile("" ::: "memory");
        f32x4 fwv[2][2];
#pragma unroll
        for (int bj = 0; bj < 2; ++bj)
#pragma unroll
            for (int n = 0; n < 2; ++n) fwv[bj][n] = *(const f32x4*)(fw + col0 + bj * HALF + n * 16);
        float tots[2][4];
#pragma unroll
        for (int ai = 0; ai < 2; ++ai)
#pragma unroll
            for (int m = 0; m < 4; ++m) tots[ai][m] = __hip_atomic_load(rowss + u.pm * BM + ai * HALF + wr * 64 + m * 16 + fr, __ATOMIC_RELAXED, __HIP_MEMORY_SCOPE_AGENT);
#pragma unroll
        for (int ai = 0; ai < 2; ++ai)
#pragma unroll
            for (int m = 0; m < 4; ++m) { const int row = u.pm * BM + ai * HALF + wr * 64 + m * 16 + fr; const size_t off = (size_t)row * ldc + col0;
                const float tot = tots[ai][m]; const float rs = __builtin_amdgcn_rsqf(tot * (1.0f / 1024.0f) + 1e-6f);
#pragma unroll
                for (int bj = 0; bj < 2; ++bj)
#pragma unroll
                    for (int n = 0; n < 2; ++n) *(f32x4*)(out + off + bj * HALF + n * 16) = acc[ai][bj][m][n] * rs * fwv[bj][n]; }
    }
};
template <class Epi, class Sched, bool ALIGN_EPI = false, bool SP2 = false>
__device__ __forceinline__ void gemm_phase(PG8_LAS unsigned char* lds, const Gemm g, const Sched& S, const Epi& E) {
    const int tid = threadIdx.x, wid = __builtin_amdgcn_readfirstlane(tid >> 6), lane = tid & 63, wr = wid >> 2, wc = wid & 3, fr = lane & 15, fq = lane >> 4;
    const int K = g.K, nt = K / BK;
    unsigned voffA[2], voffB[2];
#pragma unroll
    for (int i = 0; i < 2; ++i) { int R, C; stage_rc(tid * 16 + i * 8192, R, C); const int Rb = Epi::PERM ? ((R & ~31) + perm32(R & 31)) : R;
        voffA[i] = (unsigned)(R * K + C) * 2u; voffB[i] = (unsigned)(Rb * K + C) * 2u; }
    const size_t kstep = (size_t)(BK * 2);
    const size_t hstep = (size_t)HALF * K * 2;
    const size_t tstep = 2 * hstep;
    const unsigned ldsw = (unsigned)wid * 1024u;
    const int aoff = lds_byte(wr * 64 + fr, fq * 8), boff = lds_byte(wc * 32 + fr, fq * 8);
#define PG8_SA(b, h) (((b) * 2 + (h)) * HTB)
#define PG8_SB(b, h) ((4 + (b) * 2 + (h)) * HTB)
#define PG8_STAGE(bufoff, gbase, voff) do { _Pragma("unroll") for (int _i = 0; _i < 2; ++_i) \
        __builtin_amdgcn_global_load_lds((const unsigned*)((const char*)(gbase) + (voff)[_i]), (PG8_LAS unsigned*)(lds + (bufoff) + ldsw + _i * 8192), 16, 0, 0); } while (0)
#define PG8_LDA(dst, b, h) do { _Pragma("unroll") for (int m = 0; m < 4; ++m) _Pragma("unroll") for (int k = 0; k < 2; ++k) dst[m][k] = *(const PG8_LAS bf16x8*)(lds + PG8_SA(b, h) + aoff + m * 2048 + k * 1024); } while (0)
#define PG8_LDB(dst, b, h) do { _Pragma("unroll") for (int n = 0; n < 2; ++n) _Pragma("unroll") for (int k = 0; k < 2; ++k) dst[n][k] = *(const PG8_LAS bf16x8*)(lds + PG8_SB(b, h) + boff + n * 2048 + k * 1024); } while (0)
#define PG8_MMA(ai, bj, At, Bt) do { __builtin_amdgcn_s_setprio(1); _Pragma("unroll") for (int m = 0; m < 4; ++m) _Pragma("unroll") for (int n = 0; n < 2; ++n) _Pragma("unroll") for (int k = 0; k < 2; ++k) \
        acc[ai][bj][m][n] = __builtin_amdgcn_mfma_f32_16x16x32_bf16(Bt[n][k], At[m][k], acc[ai][bj][m][n], 0, 0, 0); __builtin_amdgcn_s_setprio(0); } while (0)
#define PG8_WAIT_V(n) asm volatile("s_waitcnt vmcnt(" #n ")" ::: "memory")
#define PG8_WAIT_L(n) asm volatile("s_waitcnt lgkmcnt(" #n ")" ::: "memory")
#define PG8_BAR __builtin_amdgcn_s_barrier()
#define PG8_SCHED __builtin_amdgcn_sched_barrier(0)
    Unit cur, nxt; int ui = 0;
    if (!S.next(0, cur)) return;
    f32x4 acc[2][2][4][2];
#pragma unroll
    for (int a = 0; a < 2; ++a)
#pragma unroll
        for (int b = 0; b < 2; ++b)
#pragma unroll
            for (int m = 0; m < 4; ++m)
#pragma unroll
                for (int n = 0; n < 2; ++n) acc[a][b][m][n] = (f32x4){0.f, 0.f, 0.f, 0.f};
    bf16x8 At[4][2], B0[2][2], B1[2][2];
    const char* cA = (const char*)g.A + (size_t)cur.pm * tstep; const char* cB = (const char*)g.Bt + (size_t)cur.pn * tstep;
    S.a_ready(cur);
    if constexpr (SP2) {
        PG8_STAGE(PG8_SB(0, 0), cB, voffB); PG8_STAGE(PG8_SB(0, 1), cB + hstep, voffB); PG8_STAGE(PG8_SA(0, 0), cA, voffA); PG8_STAGE(PG8_SA(0, 1), cA + hstep, voffA);
        if (wr == 1) PG8_BAR;
        PG8_WAIT_V(2); PG8_BAR;
        PG8_STAGE(PG8_SB(1, 0), cB + kstep, voffB); PG8_STAGE(PG8_SA(1, 0), cA + kstep, voffA); PG8_STAGE(PG8_SB(1, 1), cB + hstep + kstep, voffB);
        PG8_WAIT_V(6); PG8_BAR;
    } else {
        PG8_STAGE(PG8_SB(0, 0), cB, voffB); PG8_STAGE(PG8_SA(0, 0), cA, voffA); PG8_STAGE(PG8_SB(0, 1), cB + hstep, voffB); PG8_STAGE(PG8_SA(0, 1), cA + hstep, voffA);
        if (wr == 1) PG8_BAR;
        PG8_WAIT_V(4); PG8_BAR;
        PG8_STAGE(PG8_SB(1, 0), cB + kstep, voffB); PG8_STAGE(PG8_SA(1, 0), cA + kstep, voffA); PG8_STAGE(PG8_SB(1, 1), cB + hstep + kstep, voffB);
        PG8_WAIT_V(6); PG8_BAR;
    }
    for (;;) {
        const bool has_next = S.next(ui + 1, nxt);
        const char* nA = has_next ? (const char*)g.A + (size_t)nxt.pm * tstep : cA; const char* nB = has_next ? (const char*)g.Bt + (size_t)nxt.pn * tstep : cB;
        for (int t = 0; t < nt; t += 2) {
            const bool last = (t == nt - 2);
            const char* a1 = cA + (size_t)(t + 1) * kstep;
            const char* a2 = last ? nA : cA + (size_t)(t + 2) * kstep; const char* b2 = last ? nB : cB + (size_t)(t + 2) * kstep;
            const char* a3 = a2 + kstep; const char* b3 = b2 + kstep;
            if (last && has_next) S.a_ready(nxt);
            if constexpr (SP2) {
            PG8_LDB(B0, 0, 0); PG8_LDB(B1, 0, 1); PG8_SCHED; PG8_LDA(At, 0, 0); PG8_STAGE(PG8_SA(1, 1), a1 + hstep, voffA);
            PG8_WAIT_V(8); PG8_WAIT_L(0); PG8_BAR; PG8_MMA(0, 0, At, B0); PG8_MMA(0, 1, At, B1); PG8_BAR; PG8_SCHED;
            PG8_LDA(At, 0, 1); PG8_STAGE(PG8_SB(0, 0), b2, voffB); PG8_STAGE(PG8_SB(0, 1), b2 + hstep, voffB); PG8_STAGE(PG8_SA(0, 0), a2, voffA);
            PG8_WAIT_V(8); PG8_WAIT_L(0); PG8_BAR; PG8_MMA(1, 0, At, B0); PG8_MMA(1, 1, At, B1); PG8_BAR; PG8_SCHED;
            PG8_LDB(B0, 1, 0); PG8_LDB(B1, 1, 1); PG8_SCHED; PG8_LDA(At, 1, 0); PG8_STAGE(PG8_SA(0, 1), a2 + hstep, voffA);
            PG8_WAIT_V(8); PG8_WAIT_L(0); PG8_BAR; PG8_MMA(0, 0, At, B0); PG8_MMA(0, 1, At, B1); PG8_BAR; PG8_SCHED;
            PG8_LDA(At, 1, 1); PG8_STAGE(PG8_SB(1, 0), b3, voffB); PG8_STAGE(PG8_SB(1, 1), b3 + hstep, voffB); PG8_STAGE(PG8_SA(1, 0), a3, voffA);
            PG8_WAIT_V(8); PG8_WAIT_L(0); PG8_BAR; PG8_MMA(1, 0, At, B0); PG8_MMA(1, 1, At, B1); PG8_BAR; PG8_SCHED;
            } else {
            PG8_LDB(B0, 0, 0); PG8_SCHED; PG8_LDA(At, 0, 0); PG8_STAGE(PG8_SA(1, 1), a1 + hstep, voffA);
            PG8_WAIT_L(8); PG8_BAR; PG8_WAIT_L(0); PG8_MMA(0, 0, At, B0); PG8_BAR; PG8_SCHED;
            PG8_LDB(B1, 0, 1); PG8_STAGE(PG8_SB(0, 0), b2, voffB);
            PG8_BAR; PG8_WAIT_L(0); PG8_MMA(0, 1, At, B1); PG8_BAR;
            PG8_LDA(At, 0, 1); PG8_STAGE(PG8_SA(0, 0), a2, voffA);
            PG8_BAR; PG8_WAIT_L(0); PG8_MMA(1, 0, At, B0); PG8_BAR; PG8_SCHED;
            PG8_STAGE(PG8_SB(0, 1), b2 + hstep, voffB);
            PG8_WAIT_V(6); PG8_BAR; PG8_MMA(1, 1, At, B1); PG8_BAR;
            PG8_LDB(B0, 1, 0); PG8_SCHED; PG8_LDA(At, 1, 0); PG8_STAGE(PG8_SA(0, 1), a2 + hstep, voffA);
            PG8_WAIT_L(8); PG8_BAR; PG8_WAIT_L(0); PG8_MMA(0, 0, At, B0); PG8_BAR; PG8_SCHED;
            PG8_LDB(B1, 1, 1); PG8_STAGE(PG8_SB(1, 0), b3, voffB);
            PG8_BAR; PG8_WAIT_L(0); PG8_MMA(0, 1, At, B1); PG8_BAR;
            PG8_LDA(At, 1, 1); PG8_STAGE(PG8_SA(1, 0), a3, voffA);
            PG8_BAR; PG8_WAIT_L(0); PG8_MMA(1, 0, At, B0); PG8_BAR; PG8_SCHED;
            PG8_STAGE(PG8_SB(1, 1), b3 + hstep, voffB);
            PG8_WAIT_V(6); PG8_BAR; PG8_MMA(1, 1, At, B1); PG8_BAR;
            }
        }
        if constexpr (ALIGN_EPI) { if (wr == 0) PG8_BAR; }
        if constexpr (!Epi::AFTER_DRAIN) { E(acc, cur, wr, wc, fr, fq); S.done(cur); }
        if (!has_next) break;
#pragma unroll
        for (int a = 0; a < 2; ++a)
#pragma unroll
            for (int b = 0; b < 2; ++b)
#pragma unroll
                for (int m = 0; m < 4; ++m)
#pragma unroll
                    for (int n = 0; n < 2; ++n) acc[a][b][m][n] = (f32x4){0.f, 0.f, 0.f, 0.f};
        cur = nxt; cA = nA; cB = nB; ++ui;
        if constexpr (ALIGN_EPI) { if (wr == 1) PG8_BAR; }
    }
    PG8_WAIT_V(0);
    if constexpr (!ALIGN_EPI) { if (wr == 0) PG8_BAR; }
    PG8_BAR;
    if constexpr (Epi::AFTER_DRAIN) { E.fused(acc, cur, wr, wc, fr, fq, lds, wid, lane); S.done(cur); }
#undef PG8_SA
#undef PG8_SB
#undef PG8_STAGE
#undef PG8_LDA
#undef PG8_LDB
#undef PG8_MMA
#undef PG8_WAIT_V
#undef PG8_WAIT_L
#undef PG8_BAR
#undef PG8_SCHED
}
}

#define LAS __attribute__((address_space(3)))
typedef unsigned short bf16;
typedef short bf16x8 __attribute__((ext_vector_type(8)));
typedef short s16x4 __attribute__((ext_vector_type(4)));
typedef float f32x4 __attribute__((ext_vector_type(4)));
typedef float f32x16 __attribute__((ext_vector_type(16)));
typedef unsigned u32x4 __attribute__((ext_vector_type(4)));
constexpr int NB = 8, SEQ = 4096, NMETA = 16, DM = 1024, PADR = 48;
constexpr int LP = PADR + NMETA + SEQ;
constexpr int MP = NB * LP;
constexpr int MR = NB * SEQ;
constexpr int NP = 4352;
constexpr int DIN = 4232;
constexpr int PC_Q = 0, PC_K = 512, PC_V = 1024, PC_ZF = 1536, PC_R = 2048, PC_RK = 2560, PC_RV = 3072, PC_WD = 3584, PC_AD = 3648, PC_ZR = 3712;
constexpr float LOG2E = 1.4426950408889634f;
constexpr float QSCALE = 0.125f * LOG2E;
constexpr size_t MiB = 1u << 20;
constexpr size_t WS_WTIN = 0, WS_WTOUT = 9 * MiB, WS_LF = 11 * MiB, WS_ROWSS = 13 * MiB, WS_CTR = 13 * MiB + 512 * 1024, WS_CB = 14 * MiB, WS_U = 16 * MiB, WS_P = 82 * MiB, WS_MIX = 360 * MiB;
constexpr size_t WS_KMAX = 13 * MiB + 512 * 1024 + 4096;
constexpr size_t WS_PCNT = 13 * MiB + 256 * 1024;
constexpr int LDS_BYTES = 163840;
constexpr int NTHR = 512;

struct Prm {
    const float *x, *meta, *norm_w, *w_in, *b_f, *mu, *w0, *w_up, *a0, *a_up, *k_k, *k_a, *r_k, *gn_w, *gn_b, *w_out, *fnw;
    float* out; unsigned char* ws;
};

__device__ __forceinline__ float wave_sum(float v) {
#pragma unroll
    for (int o = 1; o < 64; o <<= 1) v += __shfl_xor(v, o);
    return v;
}
__device__ __forceinline__ unsigned f2bf(float f) { unsigned u = __builtin_bit_cast(unsigned, f); return (u + 0x7fffu + ((u >> 16) & 1u)) >> 16; }
__device__ __forceinline__ unsigned pk2(float lo, float hi) { return f2bf(lo) | (f2bf(hi) << 16); }
__device__ __forceinline__ float bf_lo(unsigned w) { return __builtin_bit_cast(float, w << 16); }
__device__ __forceinline__ float bf_hi(unsigned w) { return __builtin_bit_cast(float, w & 0xffff0000u); }
__device__ __forceinline__ void unpack8(const u32x4 w, float* f) { f[0] = bf_lo(w.x); f[1] = bf_hi(w.x); f[2] = bf_lo(w.y); f[3] = bf_hi(w.y); f[4] = bf_lo(w.z); f[5] = bf_hi(w.z); f[6] = bf_lo(w.w); f[7] = bf_hi(w.w); }
template <int CTRL> __device__ __forceinline__ float dpp_mov(float v) { return __builtin_bit_cast(float, __builtin_amdgcn_update_dpp(0, __builtin_bit_cast(int, v), CTRL, 0xf, 0xf, true)); }
__device__ __forceinline__ float reduce8(float v) { v += dpp_mov<0xB1>(v); v += dpp_mov<0x4E>(v); v += dpp_mov<0x141>(v); return v; }
__device__ __forceinline__ float fexp(float x) { return __builtin_amdgcn_exp2f(x * 1.4426950408889634f); }
__device__ __forceinline__ float sigmoidf_(float x) { return __builtin_amdgcn_rcpf(1.f + fexp(-x)); }
__device__ __forceinline__ float ftanh(float x) { return 1.f - 2.f * __builtin_amdgcn_rcpf(1.f + fexp(2.f * x)); }
__device__ __forceinline__ float flog1pexp_neg(float ax) { return __builtin_amdgcn_logf(1.f + fexp(-ax)) * 0.6931471805599453f; }
typedef float f32x2_t __attribute__((ext_vector_type(2))); typedef __bf16 bf16x2_t __attribute__((ext_vector_type(2)));
__device__ __forceinline__ unsigned cvtpk(float lo, float hi) { f32x2_t v = {lo, hi}; bf16x2_t b = __builtin_convertvector(v, bf16x2_t); return __builtin_bit_cast(unsigned, b); }
#define LDSWAIT() asm volatile("s_waitcnt lgkmcnt(0)" ::: "memory")
#define BAR_LDS() asm volatile("s_waitcnt lgkmcnt(0)\n\ts_barrier" ::: "memory")
__device__ __forceinline__ float wave_sum_dpp(float v) {
    v += dpp_mov<0xB1>(v); v += dpp_mov<0x4E>(v); v += dpp_mov<0x141>(v); v += dpp_mov<0x140>(v);
    const int vi = __builtin_bit_cast(int, v);
    return (__builtin_bit_cast(float, __builtin_amdgcn_readlane(vi, 0)) + __builtin_bit_cast(float, __builtin_amdgcn_readlane(vi, 16))) +
           (__builtin_bit_cast(float, __builtin_amdgcn_readlane(vi, 32)) + __builtin_bit_cast(float, __builtin_amdgcn_readlane(vi, 48)));
}
__device__ __forceinline__ int opaque_tid() { int t = threadIdx.x; asm volatile("" : "+v"(t)); return t; }

__device__ __forceinline__ void transpose_item(const float* W, int ldw, int srccol0, bool zero, const float* kscale, float cs, bf16* WT, int n0, int k0, LAS float* scr, int lane) {
    float v[32], sc[32];
    if (zero) {
#pragma unroll
        for (int i = 0; i < 32; ++i) { v[i] = 0.f; sc[i] = 0.f; }
    } else {
        const float* wp = W + (size_t)(k0 + (lane >> 5)) * ldw + srccol0 + (lane & 31);
#pragma unroll
        for (int i = 0; i < 32; ++i) v[i] = wp[(size_t)(2 * i) * ldw];
        if (kscale) {
#pragma unroll
            for (int i = 0; i < 32; ++i) sc[i] = kscale[k0 + 2 * i + (lane >> 5)] * cs;
        } else {
#pragma unroll
            for (int i = 0; i < 32; ++i) sc[i] = cs;
        }
    }
#pragma unroll
    for (int i = 0; i < 32; ++i) scr[(2 * i + (lane >> 5)) * 33 + (lane & 31)] = v[i] * sc[i];
    LDSWAIT();
    const int c = lane & 7;
#pragma unroll
    for (int j = 0; j < 4; ++j) { const int n = (lane >> 3) + 8 * j; const LAS float* s = scr + (8 * c) * 33 + n;
        u32x4 o; o.x = pk2(s[0 * 33], s[1 * 33]); o.y = pk2(s[2 * 33], s[3 * 33]); o.z = pk2(s[4 * 33], s[5 * 33]); o.w = pk2(s[6 * 33], s[7 * 33]);
        *(u32x4*)(WT + (size_t)(n0 + n) * DM + k0 + 8 * c) = o; }
    LDSWAIT();
}

__device__ __forceinline__ const float* p0_rowsrc(const Prm& P, int m) { const int b = m / LP, pos = m % LP; if (pos < PADR) return nullptr;
    return pos < PADR + NMETA ? P.meta + (size_t)(pos - PADR) * DM : P.x + ((size_t)b * SEQ + (pos - PADR - NMETA)) * DM; }
__device__ __forceinline__ const float* p0_rowload(const Prm& P, int m, int lane, f32x4* v) {
    const float* src = m < MP ? p0_rowsrc(P, m) : nullptr;
    if (src) {
#pragma unroll
        for (int j = 0; j < 4; ++j) v[j] = *(const f32x4*)(src + 256 * j + 4 * lane); }
    return src;
}
__device__ __forceinline__ void p0_row(const Prm& P, int m, const float* src, const f32x4* v, const LAS float* wf, bf16* U, float* LF, int lane) {
    bf16* urow = U + (size_t)m * DM;
    if (!src) {
        u32x4 z = {0u, 0u, 0u, 0u};
        *(u32x4*)(urow + lane * 8) = z; *(u32x4*)(urow + 512 + lane * 8) = z;
        if (lane < 8) LF[(size_t)m * 8 + lane] = 0.f;
        return;
    }
    float ss = 0.f;
#pragma unroll
    for (int j = 0; j < 4; ++j) ss += (v[j][0] * v[j][0] + v[j][1] * v[j][1]) + (v[j][2] * v[j][2] + v[j][3] * v[j][3]);
    ss = wave_sum_dpp(ss);
    const float rs = __builtin_amdgcn_rsqf(ss * (1.f / DM) + 1e-6f);
    float acc[8];
#pragma unroll
    for (int h = 0; h < 8; ++h) acc[h] = 0.f;
#pragma unroll
    for (int j = 0; j < 4; ++j) {
#pragma unroll
        for (int e = 0; e < 4; ++e) { const int ix = ((4 * j + e) * 64 + lane) * 4; const f32x4 w0 = *(const LAS f32x4*)(wf + ix), w1 = *(const LAS f32x4*)(wf + 4096 + ix); const float xv = v[j][e];
            acc[0] += xv * w0[0]; acc[1] += xv * w0[1]; acc[2] += xv * w0[2]; acc[3] += xv * w0[3]; acc[4] += xv * w1[0]; acc[5] += xv * w1[1]; acc[6] += xv * w1[2]; acc[7] += xv * w1[3]; }
        unsigned long long o = (unsigned long long)cvtpk(v[j][0] * rs, v[j][1] * rs) | ((unsigned long long)cvtpk(v[j][2] * rs, v[j][3] * rs) << 32);
        *(unsigned long long*)(urow + 256 * j + 4 * lane) = o;
    }
    float mine = 0.f;
#pragma unroll
    for (int h = 0; h < 8; ++h) { const float s = wave_sum_dpp(acc[h]); if (lane == h) mine = s; }
    if (lane < 8) { const float xl = mine * rs + P.b_f[lane]; const float ls = fminf(xl, 0.f) - log1pf(__expf(-fabsf(xl))); LF[(size_t)m * 8 + lane] = ls * LOG2E; }
}
__device__ __forceinline__ void p0_prologue(const Prm& P, LAS unsigned char* lds, int G) {
    const int tid = opaque_tid(), lane = tid & 63, wid = tid >> 6;
    bf16* WTin = (bf16*)(P.ws + WS_WTIN); bf16* WTout = (bf16*)(P.ws + WS_WTOUT);
    float* LF = (float*)(P.ws + WS_LF); float* rowss = (float*)(P.ws + WS_ROWSS); unsigned* ctr = (unsigned*)(P.ws + WS_CTR);
    bf16* U = (bf16*)(P.ws + WS_U);
    LAS float* scr = (LAS float*)(lds + wid * 8448);
    LAS float* wf = (LAS float*)(lds + 69632);
    const int gw = blockIdx.x * 8 + wid, NGW = G * 8;
    if (blockIdx.x == 0 && tid < 8) ctr[tid * 64] = 0u;
    for (int i = blockIdx.x * NTHR + tid; i < MR; i += G * NTHR) rowss[i] = 0.f;
    if (blockIdx.x == 1) { unsigned* pc = (unsigned*)(P.ws + WS_PCNT); for (int i = tid; i < 128 * 64; i += NTHR) pc[i] = 0u; }
    for (int i = tid; i < 8192; i += NTHR) { const int k = i >> 3, h = i & 7; const int j = k >> 8, ln = (k & 255) >> 2, e = k & 3;
        wf[(h >> 2) * 4096 + ((4 * j + e) * 64 + ln) * 4 + (h & 3)] = P.norm_w[k] * P.w_in[(size_t)k * DIN + 1536 + h]; }
    constexpr int I_IN = 16 * (NP / 32), I_OUT = 16 * 32;
    for (int it = gw; it < I_IN + I_OUT; it += NGW) {
        if (it < I_IN) { const int kb = it / (NP / 32), nb = it % (NP / 32), n0 = nb * 32;
            transpose_item(P.w_in, DIN, n0 + (n0 >= 1536 ? 8 : 0), n0 >= 4224, P.norm_w, n0 < 512 ? QSCALE : 1.f, WTin, n0, kb * 64, scr, lane); }
        else { const int r = it - I_IN, kb = r / 32, nb = r % 32; transpose_item(P.w_out, DM, nb * 32, false, nullptr, 1.f, WTout, nb * 32, kb * 64, scr, lane); }
    }
    __syncthreads();
    f32x4 vA[4], vB[4]; const float* sA = p0_rowload(P, gw, lane, vA); const float* sB = p0_rowload(P, gw + NGW, lane, vB);
    for (int m = gw; m < MP; m += 2 * NGW) {
        p0_row(P, m, sA, vA, wf, U, LF, lane); sA = p0_rowload(P, m + 2 * NGW, lane, vA);
        if (m + NGW < MP) { p0_row(P, m + NGW, sB, vB, wf, U, LF, lane); sB = p0_rowload(P, m + 3 * NGW, lane, vB); }
    }
}

__device__ __forceinline__ void cb_scan(const Prm& P, int bh, LAS unsigned char* lds) {
    const int tid = opaque_tid(), lane = tid & 63, wid = tid >> 6, b = bh >> 3, h = bh & 7;
    const float* LF = (const float*)(P.ws + WS_LF); float* CB = (float*)(P.ws + WS_CB) + (size_t)bh * LP;
    LAS float* wt = (LAS float*)lds;
    float v[9]; float s = 0.f; const int k0 = tid * 9;
    float xv[9];
#pragma unroll
    for (int i = 0; i < 9; ++i) { const int k = k0 + i; xv[i] = LF[((size_t)b * LP + (k < LP ? k : LP - 1)) * 8 + h]; }
#pragma unroll
    for (int i = 0; i < 9; ++i) { const int k = k0 + i; const float x = k < LP ? xv[i] : 0.f; s += x; v[i] = s; }
    float inc = s;
#pragma unroll
    for (int o = 1; o < 64; o <<= 1) { const float t = __shfl_up(inc, o); if (lane >= o) inc += t; }
    if (lane == 63) wt[wid] = inc;
    __syncthreads();
    float base = inc - s;
    for (int w = 0; w < wid; ++w) base += wt[w];
#pragma unroll
    for (int i = 0; i < 9; ++i) { const int k = k0 + i; if (k < LP) CB[k] = k < PADR ? -1e30f : -(base + v[i]); }
    __syncthreads();
}

__device__ __forceinline__ int crow(int r, int hi) { return (r & 3) + 8 * (r >> 2) + 4 * hi; }
__device__ __forceinline__ unsigned cvtpk_s(float lo, float hi) { unsigned r; asm volatile("v_cvt_pk_bf16_f32 %0, %1, %2" : "=v"(r) : "v"(lo), "v"(hi)); return r; }
constexpr int KCH = 1056, KSUB = 8 * KCH;
__device__ __forceinline__ void qkt(f32x16& p0, f32x16& p1, const LAS unsigned char* Kslot, const bf16x8* qr, const f32x16& c0i, const f32x16& c1i, int r32, int hi) {
    const LAS unsigned char* kb = Kslot + hi * KCH + r32 * 16;
#pragma unroll
    for (int d0 = 0; d0 < 4; ++d0) {
        const bf16x8 b0 = *(const LAS bf16x8*)(kb + d0 * 2 * KCH);
        const bf16x8 b1 = *(const LAS bf16x8*)(kb + d0 * 2 * KCH + 512);
        if (d0 == 0) { p0 = __builtin_amdgcn_mfma_f32_32x32x16_bf16(b0, qr[0], c0i, 0, 0, 0); p1 = __builtin_amdgcn_mfma_f32_32x32x16_bf16(b1, qr[0], c1i, 0, 0, 0); }
        else { p0 = __builtin_amdgcn_mfma_f32_32x32x16_bf16(b0, qr[d0], p0, 0, 0, 0); p1 = __builtin_amdgcn_mfma_f32_32x32x16_bf16(b1, qr[d0], p1, 0, 0, 0); } }
}
typedef short v4i16_t __attribute__((ext_vector_type(4)));
__device__ __forceinline__ s16x4 vtr(const LAS unsigned char* p) { return __builtin_bit_cast(s16x4, __builtin_amdgcn_ds_read_tr16_b64_v4i16((LAS v4i16_t*)p)); }
__device__ __forceinline__ void pv(f32x16* o, const LAS unsigned char* vp, bf16x8 pa0, bf16x8 pa1, bf16x8 pa2, bf16x8 pa3) {
#pragma unroll
    for (int d0 = 0; d0 < 2; ++d0) { s16x4 lo[4], hi[4];
#pragma unroll
        for (int ks = 0; ks < 4; ++ks) { lo[ks] = vtr(vp + d0 * 4096 + ks * 1024); hi[ks] = vtr(vp + d0 * 4096 + ks * 1024 + 512); }
#define PK(k) (bf16x8){lo[k][0], lo[k][1], lo[k][2], lo[k][3], hi[k][0], hi[k][1], hi[k][2], hi[k][3]}
        o[d0] = __builtin_amdgcn_mfma_f32_32x32x16_bf16(pa0, PK(0), o[d0], 0, 0, 0);
        o[d0] = __builtin_amdgcn_mfma_f32_32x32x16_bf16(pa1, PK(1), o[d0], 0, 0, 0);
        o[d0] = __builtin_amdgcn_mfma_f32_32x32x16_bf16(pa2, PK(2), o[d0], 0, 0, 0);
        o[d0] = __builtin_amdgcn_mfma_f32_32x32x16_bf16(pa3, PK(3), o[d0], 0, 0, 0);
#undef PK
    }
}
constexpr int AL_K = 0, AL_V = 4 * KSUB, AL_CB = AL_V + 32768, AL_WSF = AL_CB + 16640, AL_UIDX = AL_WSF + 2048, AL_STOP = AL_UIDX + 64;
struct KVStage { u32x4 k0, k1, v0, v1; };

__device__ __forceinline__ void attn_sub(int t, int NT, const LAS unsigned char* Ks, const LAS unsigned char* vb, const LAS float* cbl, LAS float* wsf, const bf16x8* qr,
                                         int qpos, int r32, int hi, float& m_run, float& l_run, f32x16* o) {
        f32x16 p0, p1, c0i, c1i;
        const int kvb = t * 64 + 4 * hi;
#pragma unroll
        for (int g = 0; g < 4; ++g) { const f32x4 c0 = *(const LAS f32x4*)(cbl + kvb + 8 * g), c1 = *(const LAS f32x4*)(cbl + kvb + 32 + 8 * g);
#pragma unroll
            for (int e = 0; e < 4; ++e) { c0i[4 * g + e] = c0[e] - m_run; c1i[4 * g + e] = c1[e] - m_run; } }
        qkt(p0, p1, Ks, qr, c0i, c1i, r32, hi);
        if (t >= NT - 4) {
#pragma unroll
            for (int r = 0; r < 16; ++r) { const int kv = t * 64 + crow(r, hi); if (kv > qpos) p0[r] = -INFINITY; if (kv + 32 > qpos) p1[r] = -INFINITY; }
        }
        float rm = __builtin_fmaxf(p0[0], p1[0]);
#pragma unroll
        for (int r = 1; r < 16; ++r) rm = __builtin_fmaxf(__builtin_fmaxf(rm, p0[r]), p1[r]);
        { auto rr = __builtin_amdgcn_permlane32_swap(__float_as_uint(rm), __float_as_uint(rm), false, false); rm = fmaxf(__uint_as_float(rr[0]), __uint_as_float(rr[1])); }
        if (__any(rm > 32.f)) {
            const float dl = fmaxf(rm, 0.f); const float f = __builtin_amdgcn_exp2f(-dl); m_run += dl; l_run *= f;
#pragma unroll
            for (int r = 0; r < 16; ++r) { p0[r] -= dl; p1[r] -= dl; }
            if (hi == 0) wsf[r32] = f;
            LDSWAIT();
#pragma unroll
            for (int r = 0; r < 16; ++r) { const float fr_ = wsf[crow(r, hi)]; o[0][r] *= fr_; o[1][r] *= fr_; }
        }
        float sum = 0.f;
#pragma unroll
        for (int r = 0; r < 16; ++r) { p0[r] = __builtin_amdgcn_exp2f(p0[r]); p1[r] = __builtin_amdgcn_exp2f(p1[r]); sum += p0[r] + p1[r]; }
        l_run += sum;
        u32x4 pw0, pw1, pw2, pw3;
        pw0 = (u32x4){cvtpk(p0[0], p0[1]), cvtpk(p0[2], p0[3]), cvtpk(p0[4], p0[5]), cvtpk(p0[6], p0[7])};
        pw1 = (u32x4){cvtpk(p0[8], p0[9]), cvtpk(p0[10], p0[11]), cvtpk(p0[12], p0[13]), cvtpk(p0[14], p0[15])};
        pw2 = (u32x4){cvtpk(p1[0], p1[1]), cvtpk(p1[2], p1[3]), cvtpk(p1[4], p1[5]), cvtpk(p1[6], p1[7])};
        pw3 = (u32x4){cvtpk(p1[8], p1[9]), cvtpk(p1[10], p1[11]), cvtpk(p1[12], p1[13]), cvtpk(p1[14], p1[15])};
        pv(o, vb, __builtin_bit_cast(bf16x8, pw0), __builtin_bit_cast(bf16x8, pw1), __builtin_bit_cast(bf16x8, pw2), __builtin_bit_cast(bf16x8, pw3));
}
__device__ __forceinline__ void kv_load(KVStage& st, const bf16* ksrc, const bf16* vsrc, int t, int NT) {
    if (t < NT) { st.k0 = *(const u32x4*)(ksrc + (size_t)t * 64 * NP); st.v0 = *(const u32x4*)(vsrc + (size_t)t * 64 * NP); }
    if (t + 1 < NT) { st.k1 = *(const u32x4*)(ksrc + (size_t)(t + 1) * 64 * NP); st.v1 = *(const u32x4*)(vsrc + (size_t)(t + 1) * 64 * NP); }
}
__device__ __forceinline__ void kv_store(const KVStage& st, LAS unsigned char* lds, int kdst, int vdst, int slot, int t, int NT) {
    if (t < NT) { *(LAS u32x4*)(lds + kdst + slot * 2 * KSUB) = st.k0; *(LAS u32x4*)(lds + vdst + slot * 16384) = st.v0; }
    if (t + 1 < NT) { *(LAS u32x4*)(lds + kdst + slot * 2 * KSUB + KSUB) = st.k1; *(LAS u32x4*)(lds + vdst + slot * 16384 + 8192) = st.v1; }
}
__device__ __forceinline__ bool attn_period(int p, int NT, LAS unsigned char* lds, const bf16* ksrc, const bf16* vsrc, int kdst, int vdst, const LAS float* cbl, LAS float* wsf, const bf16x8* qr,
                                            int qpos, const LAS unsigned char* vb0, int r32, int hi, int wid, float qbound, float& m_run, float& l_run, f32x16* o, KVStage& sw, KVStage& sl) {
    const int cur = p & 1, t = 2 * p;
    if (p >= 2) kv_load(sl, ksrc, vsrc, t - 4, NT);
    const int qlast = (qpos | 31);
    if (t + 1 < NT && (t + 1) * 64 <= qlast) attn_sub(t + 1, NT, lds + AL_K + cur * 2 * KSUB + KSUB, vb0 + cur * 16384 + 8192, cbl, wsf, qr, qpos, r32, hi, m_run, l_run, o);
    if (t * 64 <= qlast) attn_sub(t, NT, lds + AL_K + cur * 2 * KSUB, vb0 + cur * 16384, cbl, wsf, qr, qpos, r32, hi, m_run, l_run, o);
    LAS unsigned* stopf = (LAS unsigned*)(lds + AL_STOP) + cur * 8;
    { const bool done = (p > 0) && __all(qbound + cbl[t * 64 - 1] - m_run < -160.f); if ((r32 | hi) == 0) stopf[wid] = done ? 1u : 0u; }
    if (p >= 2) asm volatile("s_waitcnt vmcnt(4)" ::: "memory"); else asm volatile("s_waitcnt vmcnt(0)" ::: "memory");
    if (p >= 1) kv_store(sw, lds, kdst, vdst, cur ^ 1, t - 2, NT);
    BAR_LDS();
    const u32x4 f0 = *(const LAS u32x4*)stopf, f1 = *(const LAS u32x4*)(stopf + 4);
    return (f0.x & f0.y & f0.z & f0.w & f1.x & f1.y & f1.z & f1.w) != 0u;
}

__device__ __forceinline__ void attn_unit(const Prm& P, int bh, int qb, LAS unsigned char* lds) {
    const int tid = opaque_tid(), lane = tid & 63, r32 = lane & 31, hi = lane >> 5; const int wid = __builtin_amdgcn_readfirstlane(tid >> 6);
    const int b = bh >> 3, h = bh & 7;
    const int q0 = 64 + 256 * qb, NT = (q0 + 256) / 64;
    const bf16* Pb = (const bf16*)(P.ws + WS_P) + (size_t)b * LP * NP;
    LAS float* cbl = (LAS float*)(lds + AL_CB); LAS float* wsf = (LAS float*)(lds + AL_WSF) + wid * 64;
    { const float* CB = (const float*)(P.ws + WS_CB) + (size_t)bh * LP; const int lim = q0 + 256; f32x4 cv[3];
#pragma unroll
      for (int i = 0; i < 3; ++i) { const int k = 4 * tid + 2048 * i; cv[i] = *(const f32x4*)(CB + (k < lim ? k : 0)); }
#pragma unroll
      for (int i = 0; i < 3; ++i) { const int k = 4 * tid + 2048 * i; if (k < lim) *(LAS f32x4*)(cbl + k) = cv[i]; } }
    const int krow = tid >> 3, kch = tid & 7;
    const bf16* ksrc = Pb + (size_t)krow * NP + PC_K + h * 64 + kch * 8; const int kdst = AL_K + kch * KCH + krow * 16;
    const int vrow = 16 * (wid & 3) + (lane >> 2), vd = 32 * (wid >> 2) + (lane & 3) * 8;
    const bf16* vsrc = Pb + (size_t)vrow * NP + PC_V + h * 64 + vd; const int vdst = AL_V + wid * 1024 + lane * 16;
    KVStage sA, sB;
    const int NPER = (NT + 1) / 2;
    kv_load(sB, ksrc, vsrc, 2 * (NPER - 1), NT); kv_load(sA, ksrc, vsrc, 2 * (NPER - 2), NT);
    const int qpos = q0 + wid * 32 + r32;
    const bf16* Qw = Pb + (size_t)qpos * NP + PC_Q + h * 64;
    bf16x8 qr[4];
#pragma unroll
    for (int d0 = 0; d0 < 4; ++d0) qr[d0] = *(const bf16x8*)(Qw + d0 * 16 + hi * 8);
    kv_store(sB, lds, kdst, vdst, (NPER - 1) & 1, 2 * (NPER - 1), NT);
    __syncthreads();
    const LAS unsigned char* vb0 = lds + AL_V + ((lane >> 4) & 1) * 32 + (lane & 3) * 8 + (4 * hi + ((lane & 15) >> 2)) * 64;
    float m_run = 0.f, l_run = 0.f; f32x16 o[2];
    o[0] = f32x16{}; o[1] = f32x16{};
    asm volatile("" : "+v"(qr[0]), "+v"(qr[1]), "+v"(qr[2]), "+v"(qr[3]));
    float qbound;
    { float sq = 0.f;
#pragma unroll
      for (int d0 = 0; d0 < 4; ++d0)
#pragma unroll
          for (int e = 0; e < 8; ++e) { const float v = __builtin_bit_cast(float, (unsigned)(unsigned short)qr[d0][e] << 16); sq += v * v; }
      auto rr = __builtin_amdgcn_permlane32_swap(__float_as_uint(sq), __float_as_uint(sq), false, false); sq = __uint_as_float(rr[0]) + __uint_as_float(rr[1]);
      qbound = sqrtf(sq) * ((const float*)(P.ws + WS_KMAX))[bh] * 1.02f + 1.f; }
    for (int p = NPER - 1; p >= 0; p -= 2) {
        if (attn_period(p, NT, lds, ksrc, vsrc, kdst, vdst, cbl, wsf, qr, qpos, vb0, r32, hi, wid, qbound, m_run, l_run, o, sA, sB)) break;
        if (p >= 1 && attn_period(p - 1, NT, lds, ksrc, vsrc, kdst, vdst, cbl, wsf, qr, qpos, vb0, r32, hi, wid, qbound, m_run, l_run, o, sB, sA)) break;
    }
    const float l_tot = l_run + __shfl_xor(l_run, 32);
    if (hi == 0) wsf[32 + r32] = l_tot;
    LDSWAIT();
    bf16* mix = (bf16*)(P.ws + WS_MIX);
    { LAS float* stg = (LAS float*)(lds + wid * 8192);
      const int erow = lane >> 1, eh = lane & 1; const int epos = q0 + wid * 32 + erow;
      const bf16* zr = Pb + (size_t)epos * NP + PC_ZF + h * 64 + eh * 32;
      u32x4 zw[4];
#pragma unroll
      for (int i = 0; i < 4; ++i) zw[i] = *(const u32x4*)(zr + 8 * i);
#pragma unroll
      for (int r = 0; r < 16; ++r) { const int q = crow(r, hi); const float rl = __builtin_amdgcn_rcpf(wsf[32 + q]);
#pragma unroll
          for (int d0 = 0; d0 < 2; ++d0) stg[q * 64 + d0 * 32 + r32] = o[d0][r] * rl; }
      LDSWAIT();
      bf16* mr = mix + ((size_t)b * SEQ + (epos - 64)) * DM + h * 64 + eh * 32;
#pragma unroll
      for (int i = 0; i < 4; ++i) { float zf[8], ov[8]; unpack8(zw[i], zf); { const f32x4 a = *(const LAS f32x4*)(stg + erow * 64 + eh * 32 + 8 * i), c = *(const LAS f32x4*)(stg + erow * 64 + eh * 32 + 8 * i + 4); ov[0] = a[0]; ov[1] = a[1]; ov[2] = a[2]; ov[3] = a[3]; ov[4] = c[0]; ov[5] = c[1]; ov[6] = c[2]; ov[7] = c[3]; }
#pragma unroll
          for (int e = 0; e < 8; ++e) ov[e] = ov[e] * zf[e] * sigmoidf_(zf[e]);
          *(u32x4*)(mr + 8 * i) = (u32x4){cvtpk(ov[0], ov[1]), cvtpk(ov[2], ov[3]), cvtpk(ov[4], ov[5]), cvtpk(ov[6], ov[7])}; } }
    __syncthreads();
}

__device__ __forceinline__ void kmax_job(const Prm& P, int bh, LAS unsigned char* lds) {
    const int tid = opaque_tid(), b = bh >> 3, h = bh & 7;
    const bf16* Kb = (const bf16*)(P.ws + WS_P) + (size_t)b * LP * NP + PC_K + h * 64 + (tid & 7) * 8;
    LAS unsigned* mx = (LAS unsigned*)lds;
    if (tid == 0) *mx = 0u;
    __syncthreads();
    float best = 0.f;
    for (int r0 = 0; r0 < LP; r0 += 64 * 5) {
        u32x4 w[5];
#pragma unroll
        for (int i = 0; i < 5; ++i) w[i] = *(const u32x4*)(Kb + (size_t)(r0 + 64 * i + (tid >> 3)) * NP);
#pragma unroll
        for (int i = 0; i < 5; ++i) { float f[8]; unpack8(w[i], f); float sq = 0.f;
#pragma unroll
            for (int e = 0; e < 8; ++e) sq += f[e] * f[e];
            best = fmaxf(best, reduce8(sq)); }
    }
    __hip_atomic_fetch_max(mx, __float_as_uint(best), __ATOMIC_RELAXED, __HIP_MEMORY_SCOPE_WORKGROUP);
    __syncthreads();
    if (tid == 0) ((float*)(P.ws + WS_KMAX))[bh] = sqrtf(__uint_as_float(*mx));
    __syncthreads();
}

constexpr float GN_EPS = 64e-5f;
constexpr int NCHUNK = LP / 64;
constexpr int MS = 72;
constexpr int MB = 64 * MS * 2;
constexpr int PA_ACTW = 0, PA_ACTA = 8192;
constexpr int PA_AAB = 0, PA_AAK = MB, PA_ARB = 2 * MB, PA_ARK = 3 * MB;
constexpr int PA_L = 36864;
constexpr int PA_AABF = PA_L, PA_T = PA_L + 16384, PA_T11T = PA_L + 16384 + MB;
constexpr int PA_SEG = 69632, PA_TOT = PA_SEG + 2048, PA_OP = 72192;
constexpr int PA_AT = PA_OP, PA_BT = PA_OP + MB, PA_KT = PA_OP + 2 * MB, PA_RT = PA_OP + 3 * MB, PA_ATT = PA_OP + 4 * MB, PA_BHT = PA_OP + 5 * MB, PA_KHT = PA_OP + 6 * MB, PA_VT = PA_OP + 7 * MB;
constexpr int PA_AVT = PA_AT, PA_UAT = PA_BT, PA_UVT = PA_KT, PA_M2T = PA_KT;
constexpr int PA_WUPT = 147456, PA_AUPT = 155648;
static_assert(PA_OP + 8 * MB <= 146432 && PA_AUPT + 8192 <= LDS_BYTES, "pass A LDS map");
constexpr size_t WS_G = 16 * MiB, WS_Q = 16 * MiB + (size_t)NB * 8 * NCHUNK * 8192, WS_BON = 358 * MiB + 512 * 1024, WS_HV = 424 * MiB;
static_assert(WS_Q + (size_t)NB * 8 * NCHUNK * 8192 <= 82 * MiB && WS_HV + (size_t)NB * 8 * NCHUNK * 16384 <= 512 * MiB, "ws map");

__device__ __forceinline__ void load8(const float* p, float* f) { const f32x4 a = *(const f32x4*)p, b = *(const f32x4*)(p + 4); f[0] = a[0]; f[1] = a[1]; f[2] = a[2]; f[3] = a[3]; f[4] = b[0]; f[5] = b[1]; f[6] = b[2]; f[7] = b[3]; }
__device__ __forceinline__ void lload8(const LAS float* p, float* f) { const f32x4 a = *(const LAS f32x4*)p, b = *(const LAS f32x4*)(p + 4); f[0] = a[0]; f[1] = a[1]; f[2] = a[2]; f[3] = a[3]; f[4] = b[0]; f[5] = b[1]; f[6] = b[2]; f[7] = b[3]; }
__device__ __forceinline__ void shift8(const bf16* cur, const bf16* prev, bool has_prev, const float* mu, float* out) {
    float c[8], p[8], m[8];
    const u32x4 cw = *(const u32x4*)cur; u32x4 pw = *(const u32x4*)(has_prev ? prev : cur);
    load8(mu, m);
    if (!has_prev) pw = (u32x4){0u, 0u, 0u, 0u};
    unpack8(cw, c); unpack8(pw, p);
#pragma unroll
    for (int i = 0; i < 8; ++i) out[i] = c[i] + m[i] * (p[i] - c[i]);
}
__device__ __forceinline__ float ldbf(const bf16* p) { return __builtin_bit_cast(float, (unsigned)(*p) << 16); }
template <int KS> __device__ __forceinline__ f32x16 mm_tile(const LAS unsigned char* a, const LAS unsigned char* b, f32x16 acc, int r32, int hi) {
#pragma unroll
    for (int ks = 0; ks < KS; ++ks) { const bf16x8 af = *(const LAS bf16x8*)(a + (r32 * MS + hi * 8 + ks * 16) * 2), bfr = *(const LAS bf16x8*)(b + (r32 * MS + hi * 8 + ks * 16) * 2);
        acc = __builtin_amdgcn_mfma_f32_32x32x16_bf16(af, bfr, acc, 0, 0, 0); }
    return acc;
}
__device__ __forceinline__ void st_rm(LAS unsigned char* d, const f32x16& acc, int r32, int hi) {
#pragma unroll
    for (int r = 0; r < 16; r += 2) { const unsigned w = cvtpk(acc[r], acc[r + 1]); *(LAS bf16*)(d + (crow(r, hi) * MS + r32) * 2) = (bf16)(w & 0xffffu); *(LAS bf16*)(d + (crow(r + 1, hi) * MS + r32) * 2) = (bf16)(w >> 16); }
}
__device__ __forceinline__ void st_tr(LAS unsigned char* d, const f32x16& acc, int r32, int hi) {
#pragma unroll
    for (int g = 0; g < 4; ++g) { const unsigned long long w = (unsigned long long)cvtpk(acc[4 * g], acc[4 * g + 1]) | ((unsigned long long)cvtpk(acc[4 * g + 2], acc[4 * g + 3]) << 32);
        *(LAS unsigned long long*)(d + (r32 * MS + 8 * g + 4 * hi) * 2) = w; }
}

struct PAPre { u32x4 cwd, cad, pwd, pad; unsigned gr[9], gk[9], gv[9]; float sc[8]; f32x4 mw0, mw1, ma0, ma1; };
__device__ __forceinline__ void pa_prefetch(const Prm& P, int unit, PAPre& pf, int tid, int lane, int wid) {
    const int bh = unit / NCHUNK, ck = unit % NCHUNK, b = bh >> 3, h = bh & 7;
    const bf16* Pb = (const bf16*)(P.ws + WS_P) + (size_t)b * LP * NP;
    { const int tt = tid >> 3, cg = tid & 7; const int t = ck * 64 + tt; const bf16* prow = Pb + (size_t)t * NP; const bf16* qrow = t > 0 ? prow - NP : prow;
      pf.cwd = *(const u32x4*)(prow + PC_WD + cg * 8); pf.cad = *(const u32x4*)(prow + PC_AD + cg * 8);
      pf.pwd = *(const u32x4*)(qrow + PC_WD + cg * 8); pf.pad = *(const u32x4*)(qrow + PC_AD + cg * 8);
      pf.mw0 = *(const f32x4*)(P.mu + 1536 + cg * 8); pf.mw1 = *(const f32x4*)(P.mu + 1540 + cg * 8); pf.ma0 = *(const f32x4*)(P.mu + 1600 + cg * 8); pf.ma1 = *(const f32x4*)(P.mu + 1604 + cg * 8); }
    { const int hc = h * 64 + lane; pf.sc[0] = P.mu[hc]; pf.sc[1] = P.mu[512 + hc]; pf.sc[2] = P.mu[1024 + hc]; pf.sc[3] = P.w0[hc]; pf.sc[4] = P.a0[hc]; pf.sc[5] = P.k_k[hc]; pf.sc[6] = P.k_a[hc]; pf.sc[7] = P.r_k[hc]; }
    { const int hc_ = h * 64 + lane, t0_ = ck * 64 + 8 * wid;
#pragma unroll
      for (int i = 0; i < 9; ++i) { const int t_ = t0_ - 1 + i; const bf16* q = Pb + (size_t)(t_ < 0 ? 0 : t_) * NP + hc_; pf.gr[i] = q[PC_R]; pf.gk[i] = q[PC_RK]; pf.gv[i] = q[PC_RV]; } }
}

__device__ __forceinline__ void rwkv_pass_a(const Prm& P, int unit, LAS unsigned char* lds, int& cur_head, PAPre& pf, int next_unit) {
    const int tid = opaque_tid(), lane = tid & 63, r32 = lane & 31, hi = lane >> 5; const int wid = __builtin_amdgcn_readfirstlane(tid >> 6);
    const int bh = unit / NCHUNK, ck = unit % NCHUNK, b = bh >> 3, h = bh & 7;
    const bf16* Pb = (const bf16*)(P.ws + WS_P) + (size_t)b * LP * NP;
    unsigned gr[9], gk[9], gv[9];
#pragma unroll
    for (int i = 0; i < 9; ++i) { gr[i] = pf.gr[i]; gk[i] = pf.gk[i]; gv[i] = pf.gv[i]; }
    if (ck * 64 + 8 * wid == 0) { gr[0] = 0u; gk[0] = 0u; gv[0] = 0u; }
    if (h != cur_head) { cur_head = h; const int c = tid & 63, jg = tid >> 6; float w[8], a[8];
#pragma unroll
        for (int i = 0; i < 8; ++i) { w[i] = P.w_up[(size_t)(jg * 8 + i) * 512 + h * 64 + c]; a[i] = P.a_up[(size_t)(jg * 8 + i) * 512 + h * 64 + c]; }
        *(LAS u32x4*)(lds + PA_WUPT + (c * 64 + jg * 8) * 2) = (u32x4){pk2(w[0], w[1]), pk2(w[2], w[3]), pk2(w[4], w[5]), pk2(w[6], w[7])};
        *(LAS u32x4*)(lds + PA_AUPT + (c * 64 + jg * 8) * 2) = (u32x4){pk2(a[0], a[1]), pk2(a[2], a[3]), pk2(a[4], a[5]), pk2(a[6], a[7])}; }
    { const int tt = tid >> 3, cg = tid & 7; const int t = ck * 64 + tt; const bool hp = t > 0;
      float xs[8], ys[8];
      const u32x4 cwd = pf.cwd, cad = pf.cad; u32x4 pwd = pf.pwd, pad = pf.pad;
      const float mw[8] = {pf.mw0[0], pf.mw0[1], pf.mw0[2], pf.mw0[3], pf.mw1[0], pf.mw1[1], pf.mw1[2], pf.mw1[3]}, ma[8] = {pf.ma0[0], pf.ma0[1], pf.ma0[2], pf.ma0[3], pf.ma1[0], pf.ma1[1], pf.ma1[2], pf.ma1[3]};
      if (!hp) { pwd = (u32x4){0u, 0u, 0u, 0u}; pad = pwd; }
      { float c[8], p[8]; unpack8(cwd, c); unpack8(pwd, p);
#pragma unroll
        for (int i = 0; i < 8; ++i) xs[i] = ftanh(c[i] + mw[i] * (p[i] - c[i]));
        unpack8(cad, c); unpack8(pad, p);
#pragma unroll
        for (int i = 0; i < 8; ++i) ys[i] = c[i] + ma[i] * (p[i] - c[i]); }
      *(LAS u32x4*)(lds + PA_ACTW + (tt * 64 + cg * 8) * 2) = (u32x4){cvtpk(xs[0], xs[1]), cvtpk(xs[2], xs[3]), cvtpk(xs[4], xs[5]), cvtpk(xs[6], xs[7])};
      *(LAS u32x4*)(lds + PA_ACTA + (tt * 64 + cg * 8) * 2) = (u32x4){cvtpk(ys[0], ys[1]), cvtpk(ys[2], ys[3]), cvtpk(ys[4], ys[5]), cvtpk(ys[6], ys[7])}; }
    __syncthreads();
    { const int sel = wid >> 2, tm = (wid >> 1) & 1, tn = wid & 1;
      const LAS unsigned char* act = lds + (sel ? PA_ACTA : PA_ACTW) + ((32 * tm + r32) * 64 + hi * 8) * 2;
      const LAS unsigned char* wt = lds + (sel ? PA_AUPT : PA_WUPT) + ((32 * tn + r32) * 64 + hi * 8) * 2;
      f32x16 acc = {};
#pragma unroll
      for (int ks = 0; ks < 4; ++ks) { const bf16x8 af = *(const LAS bf16x8*)(act + ks * 32), bfr = *(const LAS bf16x8*)(wt + ks * 32); acc = __builtin_amdgcn_mfma_f32_32x32x16_bf16(af, bfr, acc, 0, 0, 0); }
      LAS float* lo = (LAS float*)(lds + PA_L + sel * 16384);
#pragma unroll
      for (int r = 0; r < 16; ++r) lo[(32 * tm + crow(r, hi)) * 64 + 32 * tn + r32] = acc[r]; }
    __syncthreads();
    {
        const int c = lane, hc = h * 64 + c, t0 = ck * 64 + 8 * wid;
        const float mu_r = pf.sc[0], mu_k = pf.sc[1], mu_v = pf.sc[2], w0c = pf.sc[3], a0c = pf.sc[4], kkc = pf.sc[5], kac = pf.sc[6], rkc = pf.sc[7];
        float pr = __builtin_bit_cast(float, (unsigned)gr[0] << 16), pk = __builtin_bit_cast(float, (unsigned)gk[0] << 16), pv_ = __builtin_bit_cast(float, (unsigned)gv[0] << 16);
        float lw[8], cum[8], rr[8], k2[8], vv[8], av[8], bv[8];
        float run = 0.f;
        float* bong = (float*)(P.ws + WS_BON) + (size_t)unit * 64;
#pragma unroll
        for (int i = 0; i < 8; ++i) {
            const float cr = __builtin_bit_cast(float, (unsigned)gr[i + 1] << 16), ckk = __builtin_bit_cast(float, (unsigned)gk[i + 1] << 16), cv = __builtin_bit_cast(float, (unsigned)gv[i + 1] << 16);
            rr[i] = cr + mu_r * (pr - cr); const float kx = ckk + mu_k * (pk - ckk); vv[i] = cv + mu_v * (pv_ - cv); pr = cr; pk = ckk; pv_ = cv;
            const float xw = ((const LAS float*)(lds + PA_L))[(8 * wid + i) * 64 + c] + w0c, xa = ((const LAS float*)(lds + PA_L + 16384))[(8 * wid + i) * 64 + c] + a0c;
            const float nx = -xw; const float sp = fmaxf(nx, 0.f) + flog1pexp_neg(fabsf(nx));
            lw[i] = -fexp(-sp - 0.5f); run += lw[i]; cum[i] = run;
            const float alpha = sigmoidf_(xa);
            float kn = kx * kkc; const float ss = wave_sum_dpp(kn * kn); kn *= __builtin_amdgcn_rsqf(ss + 1e-12f);
            k2[i] = kx * (1.f + (alpha - 1.f) * kac); av[i] = -kn; bv[i] = kn * alpha;
            const float bon = wave_sum_dpp(rr[i] * k2[i] * rkc);
            if (lane == 0) bong[8 * wid + i] = bon;
        }
        ((LAS float*)(lds + PA_SEG))[wid * 64 + c] = run;
        __syncthreads();
        float pre = 0.f, tot = 0.f;
#pragma unroll
        for (int g = 0; g < 8; ++g) { const float sgv = ((const LAS float*)(lds + PA_SEG))[g * 64 + c]; tot += sgv; if (g < wid) pre += sgv; }
        if (wid == 0) ((LAS float*)(lds + PA_TOT))[c] = tot;
        unsigned att[4], bht[4], kht[4], vt[4]; float tA[8], tB[8], tK[8];
#pragma unroll
        for (int i = 0; i < 8; ++i) {
            const float cm = pre + cum[i]; const float e2 = fexp(cm), e1 = fexp(cm - lw[i]), e3 = fexp(-cm), e4 = fexp(tot - cm);
            const int row = 8 * wid + i;
            tA[i] = av[i] * e1; tB[i] = bv[i] * e4; tK[i] = k2[i] * e4;
            const unsigned w0_ = cvtpk(tA[i], rr[i] * e2), w1_ = cvtpk(bv[i] * e3, k2[i] * e3);
            *(LAS bf16*)(lds + PA_AT + (row * MS + c) * 2) = (bf16)(w0_ & 0xffffu);
            *(LAS bf16*)(lds + PA_RT + (row * MS + c) * 2) = (bf16)(w0_ >> 16);
            *(LAS bf16*)(lds + PA_BT + (row * MS + c) * 2) = (bf16)(w1_ & 0xffffu);
            *(LAS bf16*)(lds + PA_KT + (row * MS + c) * 2) = (bf16)(w1_ >> 16);
        }
#pragma unroll
        for (int i = 0; i < 4; ++i) { att[i] = cvtpk(tA[2 * i], tA[2 * i + 1]); bht[i] = cvtpk(tB[2 * i], tB[2 * i + 1]); kht[i] = cvtpk(tK[2 * i], tK[2 * i + 1]); vt[i] = cvtpk(vv[2 * i], vv[2 * i + 1]); }
        *(LAS u32x4*)(lds + PA_ATT + (c * MS + 8 * wid) * 2) = (u32x4){att[0], att[1], att[2], att[3]};
        *(LAS u32x4*)(lds + PA_BHT + (c * MS + 8 * wid) * 2) = (u32x4){bht[0], bht[1], bht[2], bht[3]};
        *(LAS u32x4*)(lds + PA_KHT + (c * MS + 8 * wid) * 2) = (u32x4){kht[0], kht[1], kht[2], kht[3]};
        *(LAS u32x4*)(lds + PA_VT + (c * MS + 8 * wid) * 2) = (u32x4){vt[0], vt[1], vt[2], vt[3]};
    }
    __syncthreads();
    if (next_unit >= 0) pa_prefetch(P, next_unit, pf, tid, lane, wid);
    {
        const int mat = wid >> 1;
        const LAS unsigned char* Am = lds + ((mat & 2) ? PA_RT : PA_AT); const LAS unsigned char* Bm = lds + ((mat & 1) ? PA_KT : PA_BT);
        LAS unsigned char* D = lds + PA_AAB + mat * MB; const bool strict = mat < 2;
        if ((wid & 1) == 0) {
#pragma unroll
            for (int d = 0; d < 2; ++d) {
                f32x16 acc = {}; acc = mm_tile<4>(Am + d * 32 * MS * 2, Bm + d * 32 * MS * 2, acc, r32, hi);
#pragma unroll
                for (int r = 0; r < 16; ++r) { const int tl = crow(r, hi); const bool keep = strict ? (r32 < tl) : (r32 <= tl); acc[r] = keep ? acc[r] : 0.f; }
                st_rm(D + (d * 32 * MS + d * 32) * 2, acc, r32, hi);
                if (mat == 0) {
#pragma unroll
                    for (int r = 0; r < 16; ++r) ((LAS float*)(lds + PA_AABF))[(d * 32 + crow(r, hi)) * 64 + d * 32 + r32] = acc[r]; }
            }
        } else {
            f32x16 acc = {}; acc = mm_tile<4>(Am + 32 * MS * 2, Bm, acc, r32, hi);
            st_rm(D + (32 * MS) * 2, acc, r32, hi);
            f32x16 z = {}; st_rm(D + 32 * 2, z, r32, hi);
        }
    }
    __syncthreads();
    f32x16 yl = {}, hv = {};
    const int tm4 = (wid >> 1) & 1, tn4 = wid & 1;
    if (wid == 0) {
        const int blk = hi, c = r32; float T[32]; int offs[34];
        const LAS float* Ab = (const LAS float*)(lds + PA_AABF) + (blk * 32) * 64 + blk * 32;
        offs[0] = 0; offs[1] = 64;
#pragma unroll
        for (int t = 0; t < 32; ++t) {
            float ac4[4] = {(t == c) ? 1.f : 0.f, 0.f, 0.f, 0.f};
            const LAS float* Ar = Ab + offs[t];
#pragma unroll
            for (int s4 = 0; s4 < (t + 3) / 4; ++s4) { const f32x4 a4 = *(const LAS f32x4*)(Ar + 4 * s4);
#pragma unroll
                for (int e = 0; e < 4; ++e) if (4 * s4 + e < t) ac4[e] += a4[e] * T[4 * s4 + e]; }
            T[t] = (ac4[0] + ac4[1]) + (ac4[2] + ac4[3]);
            int ro = (t + 2) * 64; asm volatile("" : "+v"(ro), "+v"(T[t]));
            offs[t + 2] = ro;
        }
        LAS unsigned char* Td = lds + PA_T;
#pragma unroll
        for (int t = 0; t < 32; ++t) { *(LAS bf16*)(Td + ((blk * 32 + t) * MS + blk * 32 + c) * 2) = (bf16)f2bf(T[t]); if (blk == 0) *(LAS bf16*)(Td + (t * MS + 32 + c) * 2) = 0; }
        if (blk == 0) {
#pragma unroll
            for (int g = 0; g < 4; ++g) *(LAS u32x4*)(lds + PA_T11T + (c * MS + 8 * g) * 2) = (u32x4){pk2(T[8 * g], T[8 * g + 1]), pk2(T[8 * g + 2], T[8 * g + 3]), pk2(T[8 * g + 4], T[8 * g + 5]), pk2(T[8 * g + 6], T[8 * g + 7])}; }
    } else if (wid >= 4) {
        const LAS unsigned char* Vb = lds + PA_VT + tn4 * 32 * MS * 2;
        f32x16 av_ = {}; av_ = mm_tile<4>(lds + PA_AAK + tm4 * 32 * MS * 2, Vb, av_, r32, hi);
        yl = mm_tile<4>(lds + PA_ARK + tm4 * 32 * MS * 2, Vb, yl, r32, hi);
        hv = mm_tile<4>(lds + PA_KHT + tm4 * 32 * MS * 2, Vb, hv, r32, hi);
        st_tr(lds + PA_AVT + (tn4 * 32 * MS + tm4 * 32) * 2, av_, r32, hi);
    }
    __syncthreads();
    if (wid == 0) { f32x16 acc = {}; acc = mm_tile<2>(lds + PA_AAB + 32 * MS * 2, lds + PA_T11T, acc, r32, hi); st_tr(lds + PA_M2T, acc, r32, hi); }
    __syncthreads();
    if (wid == 0) { f32x16 acc = {}; acc = mm_tile<2>(lds + PA_T + (32 * MS + 32) * 2, lds + PA_M2T, acc, r32, hi); st_rm(lds + PA_T + (32 * MS) * 2, acc, r32, hi); }
    __syncthreads();
    { f32x16 acc = {}; const LAS unsigned char* Bsrc = lds + (wid < 4 ? PA_ATT : PA_AVT) + tn4 * 32 * MS * 2;
      acc = mm_tile<4>(lds + PA_T + tm4 * 32 * MS * 2, Bsrc, acc, r32, hi);
      __syncthreads();
      st_tr(lds + (wid < 4 ? PA_UAT : PA_UVT) + (tn4 * 32 * MS + tm4 * 32) * 2, acc, r32, hi); }
    __syncthreads();
    if (wid < 4) {
        const LAS unsigned char* Ub = lds + PA_UAT + tn4 * 32 * MS * 2;
        f32x16 q = {}; q = mm_tile<4>(lds + PA_ARB + tm4 * 32 * MS * 2, Ub, q, r32, hi);
        f32x16 g = {}; g = mm_tile<4>(lds + PA_BHT + tm4 * 32 * MS * 2, Ub, g, r32, hi);
        bf16* Qg = (bf16*)(P.ws + WS_Q) + (size_t)unit * 4096; bf16* Gg = (bf16*)(P.ws + WS_G) + (size_t)unit * 4096;
        const float pc = __expf(((const LAS float*)(lds + PA_TOT))[tn4 * 32 + r32]);
#pragma unroll
        for (int r = 0; r < 16; ++r) { const int row = tm4 * 32 + crow(r, hi), col = tn4 * 32 + r32;
            const float rt = __builtin_bit_cast(float, (unsigned)(*(const LAS bf16*)(lds + PA_RT + (row * MS + col) * 2)) << 16);
            const unsigned w = cvtpk(q[r] + rt, g[r] + (row == col ? pc : 0.f)); Qg[row * 64 + col] = (bf16)(w & 0xffffu); Gg[row * 64 + col] = (bf16)(w >> 16); }
    } else {
        const LAS unsigned char* Ub = lds + PA_UVT + tn4 * 32 * MS * 2;
        yl = mm_tile<4>(lds + PA_ARB + tm4 * 32 * MS * 2, Ub, yl, r32, hi);
        hv = mm_tile<4>(lds + PA_BHT + tm4 * 32 * MS * 2, Ub, hv, r32, hi);
        float* HVg = (float*)(P.ws + WS_HV) + (size_t)unit * 4096 + ((wid & 3) * 64 + lane) * 16;
#pragma unroll
        for (int g = 0; g < 4; ++g) *(f32x4*)(HVg + 4 * g) = (f32x4){hv[4 * g], hv[4 * g + 1], hv[4 * g + 2], hv[4 * g + 3]};
        if (ck >= 1) { bf16* mix = (bf16*)(P.ws + WS_MIX) + ((size_t)b * SEQ + (ck * 64 - 64)) * DM + 512 + h * 64;
#pragma unroll
            for (int r = 0; r < 16; r += 2) { const unsigned w = cvtpk(yl[r], yl[r + 1]); mix[(size_t)(tm4 * 32 + crow(r, hi)) * DM + tn4 * 32 + r32] = (bf16)(w & 0xffffu); mix[(size_t)(tm4 * 32 + crow(r + 1, hi)) * DM + tn4 * 32 + r32] = (bf16)(w >> 16); } }
    }
    __syncthreads();
}

constexpr int PB_S0 = 0, PB_S1 = MB, PB_Y = 2 * MB;
__device__ __forceinline__ void rwkv_pass_b(const Prm& P, int bh, LAS unsigned char* lds) {
    const int tid = opaque_tid(), lane = tid & 63, r32 = lane & 31, hi = lane >> 5; const int wid = __builtin_amdgcn_readfirstlane(tid >> 6);
    const int b = bh >> 3, h = bh & 7;
    const bf16* Pb = (const bf16*)(P.ws + WS_P) + (size_t)b * LP * NP;
    bf16* mix = (bf16*)(P.ws + WS_MIX);
    const int tm = (wid >> 1) & 1, tn = wid & 1;
    const int tt = tid >> 3, cg = tid & 7, hc = h * 64 + cg * 8;
    for (int i = tid; i < 2 * MB / 4; i += NTHR) ((LAS unsigned*)(lds + PB_S0))[i] = 0u;
    float gw[8], gb[8], muv[8];
    load8(P.gn_w + hc, gw); load8(P.gn_b + hc, gb); load8(P.mu + 1024 + hc, muv);
    const bf16* Abase = (const bf16*)(P.ws + (wid < 4 ? WS_G : WS_Q)) + (size_t)bh * NCHUNK * 4096 + (tm * 32 + r32) * 64 + hi * 8;
    const float* HVbase = (const float*)(P.ws + WS_HV) + (size_t)bh * NCHUNK * 4096 + ((wid & 3) * 64 + lane) * 16;
    const float* BONbase = (const float*)(P.ws + WS_BON) + (size_t)bh * NCHUNK * 64 + tt;
    bf16x8 afA[4], afB[4]; f32x4 ciA[4], ciB[4];
#define PB_LOAD(af_, ci_, ck_) do { const bf16* ag_ = Abase + (size_t)(ck_) * 4096; \
        _Pragma("unroll") for (int ks = 0; ks < 4; ++ks) af_[ks] = *(const bf16x8*)(ag_ + ks * 16); \
        if (wid < 4) { const float* hv_ = HVbase + (size_t)(ck_) * 4096; _Pragma("unroll") for (int g = 0; g < 4; ++g) ci_[g] = *(const f32x4*)(hv_ + 4 * g); } \
        else { _Pragma("unroll") for (int g = 0; g < 4; ++g) ci_[g] = (f32x4){0.f, 0.f, 0.f, 0.f}; } } while (0)
#pragma unroll
    for (int i = 0; i < 8; ++i) asm volatile("" : "+v"(gw[i]), "+v"(gb[i]), "+v"(muv[i]));
    PB_LOAD(afA, ciA, 0); PB_LOAD(afB, ciB, 1);
    u32x4 eyl = {}, evc = {}, evp = {}, ez = {}; float ebon = 0.f;
#define PB_ELOAD(ck_) do { const int t_ = (ck_) * 64 + tt; const bf16* pr_ = Pb + (size_t)t_ * NP; \
        eyl = *(const u32x4*)(mix + ((size_t)b * SEQ + (t_ - 64)) * DM + 512 + hc); evc = *(const u32x4*)(pr_ + PC_RV + hc); evp = *(const u32x4*)(pr_ - NP + PC_RV + hc); \
        ez = *(const u32x4*)(pr_ + PC_ZR + hc); ebon = BONbase[(size_t)(ck_) * 64]; } while (0)
    __syncthreads();
    for (int ck = 0; ck < NCHUNK; ++ck) {
        const int cur = ck & 1;
        const LAS unsigned char* Sb = lds + (cur ? PB_S1 : PB_S0) + (tn * 32 * MS) * 2;
        f32x16 acc;
#pragma unroll
        for (int g = 0; g < 4; ++g) { acc[4 * g] = ciA[g][0]; acc[4 * g + 1] = ciA[g][1]; acc[4 * g + 2] = ciA[g][2]; acc[4 * g + 3] = ciA[g][3]; }
#pragma unroll
        for (int ks = 0; ks < 4; ++ks) { const bf16x8 bfr = *(const LAS bf16x8*)(Sb + (r32 * MS + hi * 8 + ks * 16) * 2);
            acc = __builtin_amdgcn_mfma_f32_32x32x16_bf16(afA[ks], bfr, acc, 0, 0, 0); }
#pragma unroll
        for (int ks = 0; ks < 4; ++ks) { afA[ks] = afB[ks]; ciA[ks] = ciB[ks]; }
        if (ck + 2 < NCHUNK) PB_LOAD(afB, ciB, ck + 2);
        const u32x4 cyl = eyl, cvc = evc, cvp = evp, cz = ez; const float cbon = ebon;
        if (ck + 1 < NCHUNK) PB_ELOAD(ck + 1);
        if (wid < 4) st_tr(lds + (cur ? PB_S0 : PB_S1) + (tn * 32 * MS + tm * 32) * 2, acc, r32, hi);
        else {
#pragma unroll
            for (int r = 0; r < 16; ++r) ((LAS float*)(lds + PB_Y))[(tm * 32 + crow(r, hi)) * 64 + tn * 32 + r32] = acc[r]; }
        BAR_LDS();
        if (ck >= 1) {
            const int t = ck * 64 + tt;
            bf16* mrow = mix + ((size_t)b * SEQ + (t - 64)) * DM + 512 + hc;
            float y8[8], yl8[8], vc[8], vp[8], z8[8];
            lload8((const LAS float*)(lds + PB_Y) + tt * 64 + cg * 8, y8); unpack8(cyl, yl8); unpack8(cvc, vc); unpack8(cvp, vp); unpack8(cz, z8);
            float sm = 0.f;
#pragma unroll
            for (int i = 0; i < 8; ++i) { y8[i] += yl8[i]; sm += y8[i]; }
            const float mean = reduce8(sm) * (1.f / 64.f); float sq = 0.f;
#pragma unroll
            for (int i = 0; i < 8; ++i) { const float d = y8[i] - mean; sq += d * d; }
            const float rstd = __builtin_amdgcn_rsqf(reduce8(sq) * (1.f / 64.f) + GN_EPS);
            float o[8];
#pragma unroll
            for (int i = 0; i < 8; ++i) { const float v = vc[i] + muv[i] * (vp[i] - vc[i]); const float yn = (y8[i] - mean) * rstd * gw[i] + gb[i] + cbon * v; o[i] = yn * z8[i] * sigmoidf_(z8[i]); }
            *(u32x4*)mrow = (u32x4){cvtpk(o[0], o[1]), cvtpk(o[2], o[3]), cvtpk(o[4], o[5]), cvtpk(o[6], o[7])};
        }
        BAR_LDS();
    }
#undef PB_LOAD
#undef PB_ELOAD
    __syncthreads();
}

#define XB_TMO      128
#define XB_XCNT(j)  (256  + 64 * (j))
#define XB_XSUB(j)  (1280 + 64 * (j))
#define XB_XGEN(j)  (2304 + 64 * (j))
#define XB_TOP      3328
#define XB_TOPGEN   3392
#define XCD_BAR_WORDS 3456
#define XB_SPIN_CAP (1u << 18)

__device__ __forceinline__ unsigned xb_ld(unsigned* p)              { return __hip_atomic_load(p, __ATOMIC_RELAXED, __HIP_MEMORY_SCOPE_AGENT); }
__device__ __forceinline__ unsigned xb_add(unsigned* p, unsigned v) { return __hip_atomic_fetch_add(p, v, __ATOMIC_RELAXED, __HIP_MEMORY_SCOPE_AGENT); }
__device__ __forceinline__ unsigned xb_xcc_id() { return (unsigned)__builtin_amdgcn_s_getreg((3 << 11) | 20) & 0xFu; }
#define XB_SPIN(cond, bar) do { unsigned _sp = 0; while (cond) { __builtin_amdgcn_s_sleep(1); \
    if ((++_sp & 255u) == 0u) { if (xb_ld(&(bar)[XB_TMO])) break; if (_sp > XB_SPIN_CAP) { atomicAdd(&(bar)[XB_TMO], 1u); break; } } } } while (0)

struct XcdBarrier {
    unsigned* bar; unsigned x;
    volatile LAS unsigned* st;
};

__device__ __forceinline__ XcdBarrier xcd_barrier_post(unsigned* bar, volatile LAS unsigned* st) {
    XcdBarrier b; b.bar = bar; b.x = xb_xcc_id(); b.st = st;
    if (threadIdx.x == 0) (void)xb_add(&bar[XB_XCNT(b.x)], 1u);
    return b;
}
__device__ __forceinline__ void xcd_barrier_complete(unsigned* bar, unsigned x, unsigned& nloc, unsigned& nx) {
    const unsigned G = gridDim.x * gridDim.y * gridDim.z;
    unsigned sum, cnt, mine, sp = 0u;
    for (;;) {
        sum = 0u; cnt = 0u; mine = 0u;
#pragma unroll
        for (unsigned j = 0; j < 16; ++j) { const unsigned c = xb_ld(&bar[XB_XCNT(j)]); sum += c; cnt += (c > 0u) ? 1u : 0u; mine = (j == x) ? c : mine; }
        if (sum == G) break;
        __builtin_amdgcn_s_sleep(1);
        if ((++sp & 255u) == 0u) { if (xb_ld(&bar[XB_TMO])) break; if (sp > XB_SPIN_CAP) { atomicAdd(&bar[XB_TMO], 1u); break; } }
    }
    nloc = mine > 0u ? mine : 1u; nx = cnt > 0u ? cnt : 1u;
}

__device__ __forceinline__ void xcd_barrier(const XcdBarrier& b) {
    asm volatile("s_waitcnt vmcnt(0)" ::: "memory");
    __syncthreads();
    if (threadIdx.x == 0) {
        unsigned* bar = b.bar;
        __builtin_amdgcn_s_waitcnt(0);
        unsigned nloc = b.st[0], nx = b.st[1];
        if (nloc == 0u) { xcd_barrier_complete(bar, b.x, nloc, nx); b.st[0] = nloc; b.st[1] = nx; }
        const unsigned old = xb_add(&bar[XB_XSUB(b.x)], 1u);
        const unsigned gen = old / nloc;
        if (old + 1u == (gen + 1u) * nloc) {
            __builtin_amdgcn_fence(__ATOMIC_RELEASE, "agent");
            asm volatile("s_waitcnt vmcnt(0)" ::: "memory");
            const unsigned og = xb_add(&bar[XB_TOP], 1u);
            const unsigned tg = og / nx;
            if (og + 1u == (tg + 1u) * nx) xb_add(&bar[XB_TOPGEN], 1u);
            else XB_SPIN(xb_ld(&bar[XB_TOPGEN]) == tg, bar);
            __builtin_amdgcn_fence(__ATOMIC_ACQUIRE, "agent");
            xb_add(&bar[XB_XGEN(b.x)], 1u);
            asm volatile("s_waitcnt vmcnt(0)" ::: "memory");
        } else {
            XB_SPIN(xb_ld(&bar[XB_XGEN(b.x)]) == gen, bar);
            __builtin_amdgcn_fence(__ATOMIC_ACQUIRE, "agent");
            asm volatile("s_waitcnt vmcnt(0)" ::: "memory");
        }
    }
    __syncthreads();
}

constexpr size_t WS_BAR = 13 * MiB + 768 * 1024;
constexpr int LDS_BARST = 146944;
__global__ void __launch_bounds__(NTHR, 2) hymba_fwd(Prm P) {
    extern __shared__ __attribute__((aligned(16))) unsigned char lds_raw[];
    LAS unsigned char* lds = (LAS unsigned char*)lds_raw;
    cg::grid_group grid = cg::this_grid();
    const int G = gridDim.x;
    if (threadIdx.x < 2) ((LAS unsigned*)(lds + LDS_BARST))[threadIdx.x] = 0u;
    __syncthreads();
    const XcdBarrier xbar = xcd_barrier_post((unsigned*)(P.ws + WS_BAR), (volatile LAS unsigned*)(lds + LDS_BARST));
    if (P.ws == nullptr) grid.sync();
    p0_prologue(P, lds, G);
    xcd_barrier(xbar);
    for (int j = G - 1 - (int)blockIdx.x; j < 64; j += G) cb_scan(P, j, lds);
    { pg8::Gemm g{(const pg8::bf16_t*)(P.ws + WS_U), (const pg8::bf16_t*)(P.ws + WS_WTIN), MP, NP, DM}; pg8::StaticOrder S; S.init(MP, NP, G, (int)blockIdx.x);
      pg8::EpiBf16 E{(pg8::bf16_t*)(P.ws + WS_P), NP};
      pg8::gemm_phase<pg8::EpiBf16, pg8::StaticOrder, true, true>(lds, g, S, E); }
    xcd_barrier(xbar);
    if (G == 256) { if ((blockIdx.x & 3) == 0) kmax_job(P, (int)(blockIdx.x >> 2), lds); }
    else for (int j = blockIdx.x; j < 64; j += G) kmax_job(P, j, lds);
    { const int NU = NB * 8 * NCHUNK; const int u0 = (int)(((long)blockIdx.x * NU) / G), u1 = (int)(((long)(blockIdx.x + 1) * NU) / G); int cur_head = -1;
      PAPre pf; if (u0 < u1) { const int t_ = opaque_tid(); pa_prefetch(P, u0, pf, t_, t_ & 63, __builtin_amdgcn_readfirstlane(t_ >> 6)); }
      for (int u = u0; u < u1; ++u) rwkv_pass_a(P, u, lds, cur_head, pf, u + 1 < u1 ? u + 1 : -1); }
    xcd_barrier(xbar);
    for (int bh = blockIdx.x; bh < 64; bh += G) rwkv_pass_b(P, bh, lds);
    { unsigned* ctr = (unsigned*)(P.ws + WS_CTR); LAS unsigned* uidx = (LAS unsigned*)(lds + AL_UIDX);
      const unsigned x0 = xb_xcc_id() & 7u;
      for (unsigned k = 0; k < 8u; ++k) {
          const unsigned x = (x0 + k) & 7u;
          for (;;) {
              if (threadIdx.x == 0) *uidx = atomicAdd(ctr + x * 64, 1u);
              __syncthreads();
              const unsigned u = *uidx;
              __syncthreads();
              if (u >= 128u) break;
              attn_unit(P, (int)(x * 8u + (u & 7u)), 15 - (int)(u >> 3), lds);
          }
      } }
    xcd_barrier(xbar);
    { pg8::Gemm g{(const pg8::bf16_t*)(P.ws + WS_MIX), (const pg8::bf16_t*)(P.ws + WS_WTOUT), MR, DM, DM}; pg8::StaticOrder S; S.init(MR, DM, G, (int)blockIdx.x);
      pg8::EpiResNorm E{P.x, P.out, (float*)(P.ws + WS_ROWSS), (unsigned*)(P.ws + WS_PCNT), P.fnw, DM};
      pg8::gemm_phase<pg8::EpiResNorm, pg8::StaticOrder, true, true>(lds, g, S, E); }
}

extern "C" void kernel_launch(void* const* d_in, const int* in_sizes, int n_in, void* d_out, int out_size, void* d_ws, size_t ws_size, hipStream_t stream) {
    static int grid_blocks = 0;
    if (!grid_blocks) {
        int dev = 0, cus = 0, per_cu = 0;
        (void)hipGetDevice(&dev);
        (void)hipDeviceGetAttribute(&cus, hipDeviceAttributeMultiprocessorCount, dev);
        (void)hipFuncSetAttribute((const void*)hymba_fwd, hipFuncAttributeMaxDynamicSharedMemorySize, LDS_BYTES);
        (void)hipOccupancyMaxActiveBlocksPerMultiprocessor(&per_cu, (const void*)hymba_fwd, NTHR, LDS_BYTES);
        if (per_cu < 1) { fprintf(stderr, "kernel_launch: occupancy query returned %d\n", per_cu); per_cu = 1; }
        grid_blocks = cus * 1;
        (void)hipGetLastError();
    }
    Prm p{};
    p.x = (const float*)d_in[0]; p.meta = (const float*)d_in[1]; p.norm_w = (const float*)d_in[2]; p.w_in = (const float*)d_in[3]; p.b_f = (const float*)d_in[4];
    p.mu = (const float*)d_in[5]; p.w0 = (const float*)d_in[6]; p.w_up = (const float*)d_in[7]; p.a0 = (const float*)d_in[8]; p.a_up = (const float*)d_in[9];
    p.k_k = (const float*)d_in[10]; p.k_a = (const float*)d_in[11]; p.r_k = (const float*)d_in[12]; p.gn_w = (const float*)d_in[13]; p.gn_b = (const float*)d_in[14];
    p.w_out = (const float*)d_in[15]; p.fnw = (const float*)d_in[16];
    p.out = (float*)d_out; p.ws = (unsigned char*)d_ws;
    (void)hipMemsetAsync((unsigned char*)d_ws + WS_BAR, 0, XCD_BAR_WORDS * 4, stream);
    void* args[] = {&p};
    hipError_t e = hipLaunchCooperativeKernel((const void*)hymba_fwd, dim3(grid_blocks), dim3(NTHR), args, LDS_BYTES, stream);
    if (e != hipSuccess) fprintf(stderr, "cooperative launch failed: %s (grid %d)\n", hipGetErrorString(e), grid_blocks);
}
```

```cpp
#include <hip/hip_runtime.h>
#include <hip/hip_cooperative_groups.h>
#include <cstdio>
#include <cstdint>
namespace cg = cooperative_groups;
namespace pg8 {
#define PG8_LAS __attribute__((address_space(3)))
typedef unsigned short bf16_t;
typedef short bf16x8 __attribute__((ext_vector_type(8)));
typedef float f32x4 __attribute__((ext_vector_type(4)));
typedef unsigned u32x4 __attribute__((ext_vector_type(4)));
constexpr int BM = 256, BK = 64, HALF = 128, HTB = HALF * BK * 2  , STAGE_BYTES = 8 * HTB, NXCD = 8, WGM = 8;

__host__ __device__ __forceinline__ int lds_byte(int r, int c) { const int st = (r >> 4) * 2 + (c >> 5), rr = r & 15, cc = c & 31, ob = rr * 64 + cc * 2; return st * 1024 + (ob ^ (((ob >> 9) & 1) << 5)); }
__host__ __device__ __forceinline__ void stage_rc(int b, int& R, int& C) { const int st = b / 1024, sb = b % 1024, swz = sb ^ (((sb >> 9) & 1) << 5); R = (st >> 1) * 16 + swz / 64; C = (st & 1) * 32 + (swz % 64) / 2; }
__host__ __device__ __forceinline__ int perm32(int rho) { const int n = rho >> 4, i = rho & 15; return 8 * (i >> 2) + 4 * n + (i & 3); }

struct Unit { int pm, pn; };
struct Gemm { const bf16_t* A; const bf16_t* Bt; int M, N, K; };

struct StaticOrder {
    int nM, nN, nwg, G, c;
    __host__ __device__ void init(int M, int N, int G_, int c_) { nM = M / BM; nN = N / BM; nwg = nM * nN; G = G_; c = c_; }
    __host__ __device__ bool next(int i, Unit& u) const {
        const long L = (long)i * G + c; if (L >= nwg) return false;
        int wgid = (int)L; { const int q = nwg / NXCD, r = nwg % NXCD, xcd = wgid % NXCD, off = wgid / NXCD; wgid = (xcd < r ? xcd * (q + 1) : r * (q + 1) + (xcd - r) * q) + off; }
        const int nig = WGM * nN, gid = wgid / nig, fm = gid * WGM, gsz = (nM - fm) < WGM ? (nM - fm) : WGM;
        u.pm = fm + ((wgid % nig) % gsz); u.pn = (wgid % nig) / gsz; return true;
    }
    __device__ __forceinline__ void a_ready(const Unit&) const {}
    __device__ __forceinline__ void done(const Unit&) const {}
};

__device__ __forceinline__ unsigned cvt_pk_bf16(float lo, float hi) { unsigned r; asm volatile("v_cvt_pk_bf16_f32 %0, %1, %2" : "=v"(r) : "v"(lo), "v"(hi)); return r; }
typedef float f32x2 __attribute__((ext_vector_type(2)));
struct EpiBf16 {
    static constexpr bool PERM = true, AFTER_DRAIN = false;
    bf16_t* O; int ldc;
    __device__ __forceinline__ void operator()(const f32x4 (&acc)[2][2][4][2], const Unit& u, int wr, int wc, int fr, int fq) const {
        const int row0 = u.pm * BM + wr * 64 + fr; const int col0 = u.pn * BM + wc * 32 + 8 * fq;
#pragma unroll
        for (int ai = 0; ai < 2; ++ai)
#pragma unroll
            for (int m = 0; m < 4; ++m) { bf16_t* rowp = O + (size_t)(row0 + ai * HALF + m * 16) * ldc + col0;
#pragma unroll
                for (int bj = 0; bj < 2; ++bj) { const f32x4 v0 = acc[ai][bj][m][0], v1 = acc[ai][bj][m][1];
                    u32x4 w; w.x = cvt_pk_bf16(v0[0], v0[1]); w.y = cvt_pk_bf16(v0[2], v0[3]); w.z = cvt_pk_bf16(v1[0], v1[1]); w.w = cvt_pk_bf16(v1[2], v1[3]);
                    *(u32x4*)(rowp + bj * HALF) = w; } }
    }
};
struct EpiRes {
    static constexpr bool PERM = false, AFTER_DRAIN = false;
    const float* base; float* out; float* rowss; int ldc;
    __device__ __forceinline__ void operator()(const f32x4 (&acc)[2][2][4][2], const Unit& u, int wr, int wc, int fr, int fq) const {
        const int col0 = u.pn * BM + wc * 32 + 4 * fq;
#pragma unroll
        for (int ai = 0; ai < 2; ++ai)
#pragma unroll
            for (int m = 0; m < 4; ++m) { const int row = u.pm * BM + ai * HALF + wr * 64 + m * 16 + fr; const size_t off = (size_t)row * ldc + col0; float ss = 0.f;
#pragma unroll
                for (int bj = 0; bj < 2; ++bj)
#pragma unroll
                    for (int n = 0; n < 2; ++n) { const f32x4 bs = *(const f32x4*)(base + off + bj * HALF + n * 16); const f32x4 o = bs + acc[ai][bj][m][n];
                        ss += (o[0] * o[0] + o[1] * o[1]) + (o[2] * o[2] + o[3] * o[3]); *(f32x4*)(out + off + bj * HALF + n * 16) = o; }
                ss += __shfl_xor(ss, 16); ss += __shfl_xor(ss, 32);
                if (fq == 0) atomicAdd(rowss + row, ss); }
    }
};
struct EpiResNorm {
    static constexpr bool PERM = false, AFTER_DRAIN = false;
    const float* base; float* out; float* rowss; unsigned* cnt; const float* fw; int ldc;
    __device__ __forceinline__ void operator()(f32x4 (&acc)[2][2][4][2], const Unit& u, int wr, int wc, int fr, int fq) const {
        const int col0 = u.pn * BM + wc * 32 + 4 * fq;
#pragma unroll
        for (int ai = 0; ai < 2; ++ai)
#pragma unroll
            for (int m = 0; m < 4; ++m) { const int row = u.pm * BM + ai * HALF + wr * 64 + m * 16 + fr; const size_t off = (size_t)row * ldc + col0; float ss = 0.f;
#pragma unroll
                for (int bj = 0; bj < 2; ++bj)
#pragma unroll
                    for (int n = 0; n < 2; ++n) { const f32x4 bs = *(const f32x4*)(base + off + bj * HALF + n * 16); const f32x4 o = bs + acc[ai][bj][m][n]; acc[ai][bj][m][n] = o;
                        ss += (o[0] * o[0] + o[1] * o[1]) + (o[2] * o[2] + o[3] * o[3]); }
                ss += __shfl_xor(ss, 16); ss += __shfl_xor(ss, 32);
                if (fq == 0) atomicAdd(rowss + row, ss); }
        asm volatile("s_waitcnt vmcnt(0)" ::: "memory");
        unsigned* pc = cnt + 64 * u.pm;
        if (fr == 0 && fq == 0) __hip_atomic_fetch_add(pc, 1u, __ATOMIC_RELAXED, __HIP_MEMORY_SCOPE_AGENT);
        { unsigned sp = 0; while (__hip_atomic_load(pc, __ATOMIC_RELAXED, __HIP_MEMORY_SCOPE_AGENT) < 32u) { __builtin_amdgcn_s_sleep(2); if (++sp > (1u << 22)) break; } }
        asm volatile("" ::: "memory");
        f32x4 fwv[2][2];
#pragma unroll
        for (int bj = 0; bj < 2; ++bj)
#pragma unroll
            for (int n = 0; n < 2; ++n) fwv[bj][n] = *(const f32x4*)(fw + col0 + bj * HALF + n * 16);
        float tots[2][4];
#pragma unroll
        for (int ai = 0; ai < 2; ++ai)
#pragma unroll
            for (int m = 0; m < 4; ++m) tots[ai][m] = __hip_atomic_load(rowss + u.pm * BM + ai * HALF + wr * 64 + m * 16 + fr, __ATOMIC_RELAXED, __HIP_MEMORY_SCOPE_AGENT);
#pragma unroll
        for (int ai = 0; ai < 2; ++ai)
#pragma unroll
            for (int m = 0; m < 4; ++m) { const int row = u.pm * BM + ai * HALF + wr * 64 + m * 16 + fr; const size_t off = (size_t)row * ldc + col0;
                const float tot = tots[ai][m]; const float rs = __builtin_amdgcn_rsqf(tot * (1.0f / 1024.0f) + 1e-6f);
#pragma unroll
                for (int bj = 0; bj < 2; ++bj)
#pragma unroll
                    for (int n = 0; n < 2; ++n) *(f32x4*)(out + off + bj * HALF + n * 16) = acc[ai][bj][m][n] * rs * fwv[bj][n]; }
    }
};
template <class Epi, class Sched, bool ALIGN_EPI = false, bool SP2 = false>
__device__ __forceinline__ void gemm_phase(PG8_LAS unsigned char* lds, const Gemm g, const Sched& S, const Epi& E) {
    const int tid = threadIdx.x, wid = __builtin_amdgcn_readfirstlane(tid >> 6), lane = tid & 63, wr = wid >> 2, wc = wid & 3, fr = lane & 15, fq = lane >> 4;
    const int K = g.K, nt = K / BK;
    unsigned voffA[2], voffB[2];
#pragma unroll
    for (int i = 0; i < 2; ++i) { int R, C; stage_rc(tid * 16 + i * 8192, R, C); const int Rb = Epi::PERM ? ((R & ~31) + perm32(R & 31)) : R;
        voffA[i] = (unsigned)(R * K + C) * 2u; voffB[i] = (unsigned)(Rb * K + C) * 2u; }
    const size_t kstep = (size_t)(BK * 2);
    const size_t hstep = (size_t)HALF * K * 2;
    const size_t tstep = 2 * hstep;
    const unsigned ldsw = (unsigned)wid * 1024u;
    const int aoff = lds_byte(wr * 64 + fr, fq * 8), boff = lds_byte(wc * 32 + fr, fq * 8);
#define PG8_SA(b, h) (((b) * 2 + (h)) * HTB)
#define PG8_SB(b, h) ((4 + (b) * 2 + (h)) * HTB)
#define PG8_STAGE(bufoff, gbase, voff) do { _Pragma("unroll") for (int _i = 0; _i < 2; ++_i) \
        __builtin_amdgcn_global_load_lds((const unsigned*)((const char*)(gbase) + (voff)[_i]), (PG8_LAS unsigned*)(lds + (bufoff) + ldsw + _i * 8192), 16, 0, 0); } while (0)
#define PG8_LDA(dst, b, h) do { _Pragma("unroll") for (int m = 0; m < 4; ++m) _Pragma("unroll") for (int k = 0; k < 2; ++k) dst[m][k] = *(const PG8_LAS bf16x8*)(lds + PG8_SA(b, h) + aoff + m * 2048 + k * 1024); } while (0)
#define PG8_LDB(dst, b, h) do { _Pragma("unroll") for (int n = 0; n < 2; ++n) _Pragma("unroll") for (int k = 0; k < 2; ++k) dst[n][k] = *(const PG8_LAS bf16x8*)(lds + PG8_SB(b, h) + boff + n * 2048 + k * 1024); } while (0)
#define PG8_MMA(ai, bj, At, Bt) do { __builtin_amdgcn_s_setprio(1); _Pragma("unroll") for (int m = 0; m < 4; ++m) _Pragma("unroll") for (int n = 0; n < 2; ++n) _Pragma("unroll") for (int k = 0; k < 2; ++k) \
        acc[ai][bj][m][n] = __builtin_amdgcn_mfma_f32_16x16x32_bf16(Bt[n][k], At[m][k], acc[ai][bj][m][n], 0, 0, 0); __builtin_amdgcn_s_setprio(0); } while (0)
#define PG8_WAIT_V(n) asm volatile("s_waitcnt vmcnt(" #n ")" ::: "memory")
#define PG8_WAIT_L(n) asm volatile("s_waitcnt lgkmcnt(" #n ")" ::: "memory")
#define PG8_BAR __builtin_amdgcn_s_barrier()
#define PG8_SCHED __builtin_amdgcn_sched_barrier(0)
    Unit cur, nxt; int ui = 0;
    if (!S.next(0, cur)) return;
    f32x4 acc[2][2][4][2];
#pragma unroll
    for (int a = 0; a < 2; ++a)
#pragma unroll
        for (int b = 0; b < 2; ++b)
#pragma unroll
            for (int m = 0; m < 4; ++m)
#pragma unroll
                for (int n = 0; n < 2; ++n) acc[a][b][m][n] = (f32x4){0.f, 0.f, 0.f, 0.f};
    bf16x8 At[4][2], B0[2][2], B1[2][2];
    const char* cA = (const char*)g.A + (size_t)cur.pm * tstep; const char* cB = (const char*)g.Bt + (size_t)cur.pn * tstep;
    S.a_ready(cur);
    if constexpr (SP2) {
        PG8_STAGE(PG8_SB(0, 0), cB, voffB); PG8_STAGE(PG8_SB(0, 1), cB + hstep, voffB); PG8_STAGE(PG8_SA(0, 0), cA, voffA); PG8_STAGE(PG8_SA(0, 1), cA + hstep, voffA);
        if (wr == 1) PG8_BAR;
        PG8_WAIT_V(2); PG8_BAR;
        PG8_STAGE(PG8_SB(1, 0), cB + kstep, voffB); PG8_STAGE(PG8_SA(1, 0), cA + kstep, voffA); PG8_STAGE(PG8_SB(1, 1), cB + hstep + kstep, voffB);
        PG8_WAIT_V(6); PG8_BAR;
    } else {
        PG8_STAGE(PG8_SB(0, 0), cB, voffB); PG8_STAGE(PG8_SA(0, 0), cA, voffA); PG8_STAGE(PG8_SB(0, 1), cB + hstep, voffB); PG8_STAGE(PG8_SA(0, 1), cA + hstep, voffA);
        if (wr == 1) PG8_BAR;
        PG8_WAIT_V(4); PG8_BAR;
        PG8_STAGE(PG8_SB(1, 0), cB + kstep, voffB); PG8_STAGE(PG8_SA(1, 0), cA + kstep, voffA); PG8_STAGE(PG8_SB(1, 1), cB + hstep + kstep, voffB);
        PG8_WAIT_V(6); PG8_BAR;
    }
    for (;;) {
        const bool has_next = S.next(ui + 1, nxt);
        const char* nA = has_next ? (const char*)g.A + (size_t)nxt.pm * tstep : cA; const char* nB = has_next ? (const char*)g.Bt + (size_t)nxt.pn * tstep : cB;
        for (int t = 0; t < nt; t += 2) {
            const bool last = (t == nt - 2);
            const char* a1 = cA + (size_t)(t + 1) * kstep;
            const char* a2 = last ? nA : cA + (size_t)(t + 2) * kstep; const char* b2 = last ? nB : cB + (size_t)(t + 2) * kstep;
            const char* a3 = a2 + kstep; const char* b3 = b2 + kstep;
            if (last && has_next) S.a_ready(nxt);
            if constexpr (SP2) {
            PG8_LDB(B0, 0, 0); PG8_LDB(B1, 0, 1); PG8_SCHED; PG8_LDA(At, 0, 0); PG8_STAGE(PG8_SA(1, 1), a1 + hstep, voffA);
            PG8_WAIT_V(8); PG8_WAIT_L(0); PG8_BAR; PG8_MMA(0, 0, At, B0); PG8_MMA(0, 1, At, B1); PG8_BAR; PG8_SCHED;
            PG8_LDA(At, 0, 1); PG8_STAGE(PG8_SB(0, 0), b2, voffB); PG8_STAGE(PG8_SB(0, 1), b2 + hstep, voffB); PG8_STAGE(PG8_SA(0, 0), a2, voffA);
            PG8_WAIT_V(8); PG8_WAIT_L(0); PG8_BAR; PG8_MMA(1, 0, At, B0); PG8_MMA(1, 1, At, B1); PG8_BAR; PG8_SCHED;
            PG8_LDB(B0, 1, 0); PG8_LDB(B1, 1, 1); PG8_SCHED; PG8_LDA(At, 1, 0); PG8_STAGE(PG8_SA(0, 1), a2 + hstep, voffA);
            PG8_WAIT_V(8); PG8_WAIT_L(0); PG8_BAR; PG8_MMA(0, 0, At, B0); PG8_MMA(0, 1, At, B1); PG8_BAR; PG8_SCHED;
            PG8_LDA(At, 1, 1); PG8_STAGE(PG8_SB(1, 0), b3, voffB); PG8_STAGE(PG8_SB(1, 1), b3 + hstep, voffB); PG8_STAGE(PG8_SA(1, 0), a3, voffA);
            PG8_WAIT_V(8); PG8_WAIT_L(0); PG8_BAR; PG8_MMA(1, 0, At, B0); PG8_MMA(1, 1, At, B1); PG8_BAR; PG8_SCHED;
            } else {
            PG8_LDB(B0, 0, 0); PG8_SCHED; PG8_LDA(At, 0, 0); PG8_STAGE(PG8_SA(1, 1), a1 + hstep, voffA);
            PG8_WAIT_L(8); PG8_BAR; PG8_WAIT_L(0); PG8_MMA(0, 0, At, B0); PG8_BAR; PG8_SCHED;
            PG8_LDB(B1, 0, 1); PG8_STAGE(PG8_SB(0, 0), b2, voffB);
            PG8_BAR; PG8_WAIT_L(0); PG8_MMA(0, 1, At, B1); PG8_BAR;
            PG8_LDA(At, 0, 1); PG8_STAGE(PG8_SA(0, 0), a2, voffA);
            PG8_BAR; PG8_WAIT_L(0); PG8_MMA(1, 0, At, B0); PG8_BAR; PG8_SCHED;
            PG8_STAGE(PG8_SB(0, 1), b2 + hstep, voffB);
            PG8_WAIT_V(6); PG8_BAR; PG8_MMA(1, 1, At, B1); PG8_BAR;
            PG8_LDB(B0, 1, 0); PG8_SCHED; PG8_LDA(At, 1, 0); PG8_STAGE(PG8_SA(0, 1), a2 + hstep, voffA);
            PG8_WAIT_L(8); PG8_BAR; PG8_WAIT_L(0); PG8_MMA(0, 0, At, B0); PG8_BAR; PG8_SCHED;
            PG8_LDB(B1, 1, 1); PG8_STAGE(PG8_SB(1, 0), b3, voffB);
            PG8_BAR; PG8_WAIT_L(0); PG8_MMA(0, 1, At, B1); PG8_BAR;
            PG8_LDA(At, 1, 1); PG8_STAGE(PG8_SA(1, 0), a3, voffA);
            PG8_BAR; PG8_WAIT_L(0); PG8_MMA(1, 0, At, B0); PG8_BAR; PG8_SCHED;
            PG8_STAGE(PG8_SB(1, 1), b3 + hstep, voffB);
            PG8_WAIT_V(6); PG8_BAR; PG8_MMA(1, 1, At, B1); PG8_BAR;
            }
        }
        if constexpr (ALIGN_EPI) { if (wr == 0) PG8_BAR; }
        if constexpr (!Epi::AFTER_DRAIN) { E(acc, cur, wr, wc, fr, fq); S.done(cur); }
        if (!has_next) break;
#pragma unroll
        for (int a = 0; a < 2; ++a)
#pragma unroll
            for (int b = 0; b < 2; ++b)
#pragma unroll
                for (int m = 0; m < 4; ++m)
#pragma unroll
                    for (int n = 0; n < 2; ++n) acc[a][b][m][n] = (f32x4){0.f, 0.f, 0.f, 0.f};
        cur = nxt; cA = nA; cB = nB; ++ui;
        if constexpr (ALIGN_EPI) { if (wr == 1) PG8_BAR; }
    }
    PG8_WAIT_V(0);
    if constexpr (!ALIGN_EPI) { if (wr == 0) PG8_BAR; }
    PG8_BAR;
    if constexpr (Epi::AFTER_DRAIN) { E.fused(acc, cur, wr, wc, fr, fq, lds, wid, lane); S.done(cur); }
#undef PG8_SA
#undef PG8_SB
#undef PG8_STAGE
#undef PG8_LDA
#undef PG8_LDB
#undef PG8_MMA
#undef PG8_WAIT_V
#undef PG8_WAIT_L
#undef PG8_BAR
#undef PG8_SCHED
}
}

#define LAS __attribute__((address_space(3)))
typedef unsigned short bf16;
typedef short bf16x8 __attribute__((ext_vector_type(8)));
typedef short s16x4 __attribute__((ext_vector_type(4)));
typedef float f32x4 __attribute__((ext_vector_type(4)));
typedef float f32x16 __attribute__((ext_vector_type(16)));
typedef unsigned u32x4 __attribute__((ext_vector_type(4)));
constexpr int NB = 8, SEQ = 4096, NMETA = 16, DM = 1024, PADR = 48;
constexpr int LP = PADR + NMETA + SEQ;
constexpr int MP = NB * LP;
constexpr int MR = NB * SEQ;
constexpr int NP = 4352;
constexpr int DIN = 4232;
constexpr int PC_Q = 0, PC_K = 512, PC_V = 1024, PC_ZF = 1536, PC_R = 2048, PC_RK = 2560, PC_RV = 3072, PC_WD = 3584, PC_AD = 3648, PC_ZR = 3712;
constexpr float LOG2E = 1.4426950408889634f;
constexpr float QSCALE = 0.125f * LOG2E;
constexpr size_t MiB = 1u << 20;
constexpr size_t WS_WTIN = 0, WS_WTOUT = 9 * MiB, WS_LF = 11 * MiB, WS_ROWSS = 13 * MiB, WS_CTR = 13 * MiB + 512 * 1024, WS_CB = 14 * MiB, WS_U = 16 * MiB, WS_P = 82 * MiB, WS_MIX = 360 * MiB;
constexpr size_t WS_KMAX = 13 * MiB + 512 * 1024 + 4096;
constexpr size_t WS_PCNT = 13 * MiB + 256 * 1024;
constexpr int LDS_BYTES = 163840;
constexpr int NTHR = 512;

struct Prm {
    const float *x, *meta, *norm_w, *w_in, *b_f, *mu, *w0, *w_up, *a0, *a_up, *k_k, *k_a, *r_k, *gn_w, *gn_b, *w_out, *fnw;
    float* out; unsigned char* ws;
};

__device__ __forceinline__ float wave_sum(float v) {
#pragma unroll
    for (int o = 1; o < 64; o <<= 1) v += __shfl_xor(v, o);
    return v;
}
__device__ __forceinline__ unsigned f2bf(float f) { unsigned u = __builtin_bit_cast(unsigned, f); return (u + 0x7fffu + ((u >> 16) & 1u)) >> 16; }
__device__ __forceinline__ unsigned pk2(float lo, float hi) { return f2bf(lo) | (f2bf(hi) << 16); }
__device__ __forceinline__ float bf_lo(unsigned w) { return __builtin_bit_cast(float, w << 16); }
__device__ __forceinline__ float bf_hi(unsigned w) { return __builtin_bit_cast(float, w & 0xffff0000u); }
__device__ __forceinline__ void unpack8(const u32x4 w, float* f) { f[0] = bf_lo(w.x); f[1] = bf_hi(w.x); f[2] = bf_lo(w.y); f[3] = bf_hi(w.y); f[4] = bf_lo(w.z); f[5] = bf_hi(w.z); f[6] = bf_lo(w.w); f[7] = bf_hi(w.w); }
template <int CTRL> __device__ __forceinline__ float dpp_mov(float v) { return __builtin_bit_cast(float, __builtin_amdgcn_update_dpp(0, __builtin_bit_cast(int, v), CTRL, 0xf, 0xf, true)); }
__device__ __forceinline__ float reduce8(float v) { v += dpp_mov<0xB1>(v); v += dpp_mov<0x4E>(v); v += dpp_mov<0x141>(v); return v; }
__device__ __forceinline__ float fexp(float x) { return __builtin_amdgcn_exp2f(x * 1.4426950408889634f); }
__device__ __forceinline__ float sigmoidf_(float x) { return __builtin_amdgcn_rcpf(1.f + fexp(-x)); }
__device__ __forceinline__ float ftanh(float x) { return 1.f - 2.f * __builtin_amdgcn_rcpf(1.f + fexp(2.f * x)); }
__device__ __forceinline__ float flog1pexp_neg(float ax) { return __builtin_amdgcn_logf(1.f + fexp(-ax)) * 0.6931471805599453f; }
typedef float f32x2_t __attribute__((ext_vector_type(2))); typedef __bf16 bf16x2_t __attribute__((ext_vector_type(2)));
__device__ __forceinline__ unsigned cvtpk(float lo, float hi) { f32x2_t v = {lo, hi}; bf16x2_t b = __builtin_convertvector(v, bf16x2_t); return __builtin_bit_cast(unsigned, b); }
#define LDSWAIT() asm volatile("s_waitcnt lgkmcnt(0)" ::: "memory")
#define BAR_LDS() asm volatile("s_waitcnt lgkmcnt(0)\n\ts_barrier" ::: "memory")
__device__ __forceinline__ float wave_sum_dpp(float v) {
    v += dpp_mov<0xB1>(v); v += dpp_mov<0x4E>(v); v += dpp_mov<0x141>(v); v += dpp_mov<0x140>(v);
    const int vi = __builtin_bit_cast(int, v);
    return (__builtin_bit_cast(float, __builtin_amdgcn_readlane(vi, 0)) + __builtin_bit_cast(float, __builtin_amdgcn_readlane(vi, 16))) +
           (__builtin_bit_cast(float, __builtin_amdgcn_readlane(vi, 32)) + __builtin_bit_cast(float, __builtin_amdgcn_readlane(vi, 48)));
}
__device__ __forceinline__ int opaque_tid() { int t = threadIdx.x; asm volatile("" : "+v"(t)); return t; }

__device__ __forceinline__ void transpose_item(const float* W, int ldw, int srccol0, bool zero, const float* kscale, float cs, bf16* WT, int n0, int k0, LAS float* scr, int lane) {
    float v[32], sc[32];
    if (zero) {
#pragma unroll
        for (int i = 0; i < 32; ++i) { v[i] = 0.f; sc[i] = 0.f; }
    } else {
        const float* wp = W + (size_t)(k0 + (lane >> 5)) * ldw + srccol0 + (lane & 31);
#pragma unroll
        for (int i = 0; i < 32; ++i) v[i] = wp[(size_t)(2 * i) * ldw];
        if (kscale) {
#pragma unroll
            for (int i = 0; i < 32; ++i) sc[i] = kscale[k0 + 2 * i + (lane >> 5)] * cs;
        } else {
#pragma unroll
            for (int i = 0; i < 32; ++i) sc[i] = cs;
        }
    }
#pragma unroll
    for (int i = 0; i < 32; ++i) scr[(2 * i + (lane >> 5)) * 33 + (lane & 31)] = v[i] * sc[i];
    LDSWAIT();
    const int c = lane & 7;
#pragma unroll
    for (int j = 0; j < 4; ++j) { const int n = (lane >> 3) + 8 * j; const LAS float* s = scr + (8 * c) * 33 + n;
        u32x4 o; o.x = pk2(s[0 * 33], s[1 * 33]); o.y = pk2(s[2 * 33], s[3 * 33]); o.z = pk2(s[4 * 33], s[5 * 33]); o.w = pk2(s[6 * 33], s[7 * 33]);
        *(u32x4*)(WT + (size_t)(n0 + n) * DM + k0 + 8 * c) = o; }
    LDSWAIT();
}

__device__ __forceinline__ const float* p0_rowsrc(const Prm& P, int m) { const int b = m / LP, pos = m % LP; if (pos < PADR) return nullptr;
    return pos < PADR + NMETA ? P.meta + (size_t)(pos - PADR) * DM : P.x + ((size_t)b * SEQ + (pos - PADR - NMETA)) * DM; }
__device__ __forceinline__ const float* p0_rowload(const Prm& P, int m, int lane, f32x4* v) {
    const float* src = m < MP ? p0_rowsrc(P, m) : nullptr;
    if (src) {
#pragma unroll
        for (int j = 0; j < 4; ++j) v[j] = *(const f32x4*)(src + 256 * j + 4 * lane); }
    return src;
}
__device__ __forceinline__ void p0_row(const Prm& P, int m, const float* src, const f32x4* v, const LAS float* wf, bf16* U, float* LF, int lane) {
    bf16* urow = U + (size_t)m * DM;
    if (!src) {
        u32x4 z = {0u, 0u, 0u, 0u};
        *(u32x4*)(urow + lane * 8) = z; *(u32x4*)(urow + 512 + lane * 8) = z;
        if (lane < 8) LF[(size_t)m * 8 + lane] = 0.f;
        return;
    }
    float ss = 0.f;
#pragma unroll
    for (int j = 0; j < 4; ++j) ss += (v[j][0] * v[j][0] + v[j][1] * v[j][1]) + (v[j][2] * v[j][2] + v[j][3] * v[j][3]);
    ss = wave_sum_dpp(ss);
    const float rs = __builtin_amdgcn_rsqf(ss * (1.f / DM) + 1e-6f);
    float acc[8];
#pragma unroll
    for (int h = 0; h < 8; ++h) acc[h] = 0.f;
#pragma unroll
    for (int j = 0; j < 4; ++j) {
#pragma unroll
        for (int e = 0; e < 4; ++e) { const int ix = ((4 * j + e) * 64 + lane) * 4; const f32x4 w0 = *(const LAS f32x4*)(wf + ix), w1 = *(const LAS f32x4*)(wf + 4096 + ix); const float xv = v[j][e];
            acc[0] += xv * w0[0]; acc[1] += xv * w0[1]; acc[2] += xv * w0[2]; acc[3] += xv * w0[3]; acc[4] += xv * w1[0]; acc[5] += xv * w1[1]; acc[6] += xv * w1[2]; acc[7] += xv * w1[3]; }
        unsigned long long o = (unsigned long long)cvtpk(v[j][0] * rs, v[j][1] * rs) | ((unsigned long long)cvtpk(v[j][2] * rs, v[j][3] * rs) << 32);
        *(unsigned long long*)(urow + 256 * j + 4 * lane) = o;
    }
    float mine = 0.f;
#pragma unroll
    for (int h = 0; h < 8; ++h) { const float s = wave_sum_dpp(acc[h]); if (lane == h) mine = s; }
    if (lane < 8) { const float xl = mine * rs + P.b_f[lane]; const float ls = fminf(xl, 0.f) - log1pf(__expf(-fabsf(xl))); LF[(size_t)m * 8 + lane] = ls * LOG2E; }
}
__device__ __forceinline__ void p0_prologue(const Prm& P, LAS unsigned char* lds, int G) {
    const int tid = opaque_tid(), lane = tid & 63, wid = tid >> 6;
    bf16* WTin = (bf16*)(P.ws + WS_WTIN); bf16* WTout = (bf16*)(P.ws + WS_WTOUT);
    float* LF = (float*)(P.ws + WS_LF); float* rowss = (float*)(P.ws + WS_ROWSS); unsigned* ctr = (unsigned*)(P.ws + WS_CTR);
    bf16* U = (bf16*)(P.ws + WS_U);
    LAS float* scr = (LAS float*)(lds + wid * 8448);
    LAS float* wf = (LAS float*)(lds + 69632);
    const int gw = blockIdx.x * 8 + wid, NGW = G * 8;
    if (blockIdx.x == 0 && tid < 8) ctr[tid * 64] = 0u;
    for (int i = blockIdx.x * NTHR + tid; i < MR; i += G * NTHR) rowss[i] = 0.f;
    if (blockIdx.x == 1) { unsigned* pc = (unsigned*)(P.ws + WS_PCNT); for (int i = tid; i < 128 * 64; i += NTHR) pc[i] = 0u; }
    for (int i = tid; i < 8192; i += NTHR) { const int k = i >> 3, h = i & 7; const int j = k >> 8, ln = (k & 255) >> 2, e = k & 3;
        wf[(h >> 2) * 4096 + ((4 * j + e) * 64 + ln) * 4 + (h & 3)] = P.norm_w[k] * P.w_in[(size_t)k * DIN + 1536 + h]; }
    constexpr int I_IN = 16 * (NP / 32), I_OUT = 16 * 32;
    for (int it = gw; it < I_IN + I_OUT; it += NGW) {
        if (it < I_IN) { const int kb = it / (NP / 32), nb = it % (NP / 32), n0 = nb * 32;
            transpose_item(P.w_in, DIN, n0 + (n0 >= 1536 ? 8 : 0), n0 >= 4224, P.norm_w, n0 < 512 ? QSCALE : 1.f, WTin, n0, kb * 64, scr, lane); }
        else { const int r = it - I_IN, kb = r / 32, nb = r % 32; transpose_item(P.w_out, DM, nb * 32, false, nullptr, 1.f, WTout, nb * 32, kb * 64, scr, lane); }
    }
    __syncthreads();
    f32x4 vA[4], vB[4]; const float* sA = p0_rowload(P, gw, lane, vA); const float* sB = p0_rowload(P, gw + NGW, lane, vB);
    for (int m = gw; m < MP; m += 2 * NGW) {
        p0_row(P, m, sA, vA, wf, U, LF, lane); sA = p0_rowload(P, m + 2 * NGW, lane, vA);
        if (m + NGW < MP) { p0_row(P, m + NGW, sB, vB, wf, U, LF, lane); sB = p0_rowload(P, m + 3 * NGW, lane, vB); }
    }
}

__device__ __forceinline__ void cb_scan(const Prm& P, int bh, LAS unsigned char* lds) {
    const int tid = opaque_tid(), lane = tid & 63, wid = tid >> 6, b = bh >> 3, h = bh & 7;
    const float* LF = (const float*)(P.ws + WS_LF); float* CB = (float*)(P.ws + WS_CB) + (size_t)bh * LP;
    LAS float* wt = (LAS float*)lds;
    float v[9]; float s = 0.f; const int k0 = tid * 9;
    float xv[9];
#pragma unroll
    for (int i = 0; i < 9; ++i) { const int k = k0 + i; xv[i] = LF[((size_t)b * LP + (k < LP ? k : LP - 1)) * 8 + h]; }
#pragma unroll
    for (int i = 0; i < 9; ++i) { const int k = k0 + i; const float x = k < LP ? xv[i] : 0.f; s += x; v[i] = s; }
    float inc = s;
#pragma unroll
    for (int o = 1; o < 64; o <<= 1) { const float t = __shfl_up(inc, o); if (lane >= o) inc += t; }
    if (lane == 63) wt[wid] = inc;
    __syncthreads();
    float base = inc - s;
    for (int w = 0; w < wid; ++w) base += wt[w];
#pragma unroll
    for (int i = 0; i < 9; ++i) { const int k = k0 + i; if (k < LP) CB[k] = k < PADR ? -1e30f : -(base + v[i]); }
    __syncthreads();
}

__device__ __forceinline__ int crow(int r, int hi) { return (r & 3) + 8 * (r >> 2) + 4 * hi; }
__device__ __forceinline__ unsigned cvtpk_s(float lo, float hi) { unsigned r; asm volatile("v_cvt_pk_bf16_f32 %0, %1, %2" : "=v"(r) : "v"(lo), "v"(hi)); return r; }
constexpr int KCH = 1056, KSUB = 8 * KCH;
__device__ __forceinline__ void qkt(f32x16& p0, f32x16& p1, const LAS unsigned char* Kslot, const bf16x8* qr, const f32x16& c0i, const f32x16& c1i, int r32, int hi) {
    const LAS unsigned char* kb = Kslot + hi * KCH + r32 * 16;
#pragma unroll
    for (int d0 = 0; d0 < 4; ++d0) {
        const bf16x8 b0 = *(const LAS bf16x8*)(kb + d0 * 2 * KCH);
        const bf16x8 b1 = *(const LAS bf16x8*)(kb + d0 * 2 * KCH + 512);
        if (d0 == 0) { p0 = __builtin_amdgcn_mfma_f32_32x32x16_bf16(b0, qr[0], c0i, 0, 0, 0); p1 = __builtin_amdgcn_mfma_f32_32x32x16_bf16(b1, qr[0], c1i, 0, 0, 0); }
        else { p0 = __builtin_amdgcn_mfma_f32_32x32x16_bf16(b0, qr[d0], p0, 0, 0, 0); p1 = __builtin_amdgcn_mfma_f32_32x32x16_bf16(b1, qr[d0], p1, 0, 0, 0); } }
}
typedef short v4i16_t __attribute__((ext_vector_type(4)));
__device__ __forceinline__ s16x4 vtr(const LAS unsigned char* p) { return __builtin_bit_cast(s16x4, __builtin_amdgcn_ds_read_tr16_b64_v4i16((LAS v4i16_t*)p)); }
__device__ __forceinline__ void pv(f32x16* o, const LAS unsigned char* vp, bf16x8 pa0, bf16x8 pa1, bf16x8 pa2, bf16x8 pa3) {
#pragma unroll
    for (int d0 = 0; d0 < 2; ++d0) { s16x4 lo[4], hi[4];
#pragma unroll
        for (int ks = 0; ks < 4; ++ks) { lo[ks] = vtr(vp + d0 * 4096 + ks * 1024); hi[ks] = vtr(vp + d0 * 4096 + ks * 1024 + 512); }
#define PK(k) (bf16x8){lo[k][0], lo[k][1], lo[k][2], lo[k][3], hi[k][0], hi[k][1], hi[k][2], hi[k][3]}
        o[d0] = __builtin_amdgcn_mfma_f32_32x32x16_bf16(pa0, PK(0), o[d0], 0, 0, 0);
        o[d0] = __builtin_amdgcn_mfma_f32_32x32x16_bf16(pa1, PK(1), o[d0], 0, 0, 0);
        o[d0] = __builtin_amdgcn_mfma_f32_32x32x16_bf16(pa2, PK(2), o[d0], 0, 0, 0);
        o[d0] = __builtin_amdgcn_mfma_f32_32x32x16_bf16(pa3, PK(3), o[d0], 0, 0, 0);
#undef PK
    }
}
constexpr int AL_K = 0, AL_V = 4 * KSUB, AL_CB = AL_V + 32768, AL_WSF = AL_CB + 16640, AL_UIDX = AL_WSF + 2048, AL_STOP = AL_UIDX + 64;
struct KVStage { u32x4 k0, k1, v0, v1; };

__device__ __forceinline__ void attn_sub(int t, int NT, const LAS unsigned char* Ks, const LAS unsigned char* vb, const LAS float* cbl, LAS float* wsf, const bf16x8* qr,
                                         int qpos, int r32, int hi, float& m_run, float& l_run, f32x16* o) {
        f32x16 p0, p1, c0i, c1i;
        const int kvb = t * 64 + 4 * hi;
#pragma unroll
        for (int g = 0; g < 4; ++g) { const f32x4 c0 = *(const LAS f32x4*)(cbl + kvb + 8 * g), c1 = *(const LAS f32x4*)(cbl + kvb + 32 + 8 * g);
#pragma unroll
            for (int e = 0; e < 4; ++e) { c0i[4 * g + e] = c0[e] - m_run; c1i[4 * g + e] = c1[e] - m_run; } }
        qkt(p0, p1, Ks, qr, c0i, c1i, r32, hi);
        if (t >= NT - 4) {
#pragma unroll
            for (int r = 0; r < 16; ++r) { const int kv = t * 64 + crow(r, hi); if (kv > qpos) p0[r] = -INFINITY; if (kv + 32 > qpos) p1[r] = -INFINITY; }
        }
        float rm = __builtin_fmaxf(p0[0], p1[0]);
#pragma unroll
        for (int r = 1; r < 16; ++r) rm = __builtin_fmaxf(__builtin_fmaxf(rm, p0[r]), p1[r]);
        { auto rr = __builtin_amdgcn_permlane32_swap(__float_as_uint(rm), __float_as_uint(rm), false, false); rm = fmaxf(__uint_as_float(rr[0]), __uint_as_float(rr[1])); }
        if (__any(rm > 32.f)) {
            const float dl = fmaxf(rm, 0.f); const float f = __builtin_amdgcn_exp2f(-dl); m_run += dl; l_run *= f;
#pragma unroll
            for (int r = 0; r < 16; ++r) { p0[r] -= dl; p1[r] -= dl; }
            if (hi == 0) wsf[r32] = f;
            LDSWAIT();
#pragma unroll
            for (int r = 0; r < 16; ++r) { const float fr_ = wsf[crow(r, hi)]; o[0][r] *= fr_; o[1][r] *= fr_; }
        }
        float sum = 0.f;
#pragma unroll
        for (int r = 0; r < 16; ++r) { p0[r] = __builtin_amdgcn_exp2f(p0[r]); p1[r] = __builtin_amdgcn_exp2f(p1[r]); sum += p0[r] + p1[r]; }
        l_run += sum;
        u32x4 pw0, pw1, pw2, pw3;
        pw0 = (u32x4){cvtpk(p0[0], p0[1]), cvtpk(p0[2], p0[3]), cvtpk(p0[4], p0[5]), cvtpk(p0[6], p0[7])};
        pw1 = (u32x4){cvtpk(p0[8], p0[9]), cvtpk(p0[10], p0[11]), cvtpk(p0[12], p0[13]), cvtpk(p0[14], p0[15])};
        pw2 = (u32x4){cvtpk(p1[0], p1[1]), cvtpk(p1[2], p1[3]), cvtpk(p1[4], p1[5]), cvtpk(p1[6], p1[7])};
        pw3 = (u32x4){cvtpk(p1[8], p1[9]), cvtpk(p1[10], p1[11]), cvtpk(p1[12], p1[13]), cvtpk(p1[14], p1[15])};
        pv(o, vb, __builtin_bit_cast(bf16x8, pw0), __builtin_bit_cast(bf16x8, pw1), __builtin_bit_cast(bf16x8, pw2), __builtin_bit_cast(bf16x8, pw3));
}
__device__ __forceinline__ void kv_load(KVStage& st, const bf16* ksrc, const bf16* vsrc, int t, int NT) {
    if (t < NT) { st.k0 = *(const u32x4*)(ksrc + (size_t)t * 64 * NP); st.v0 = *(const u32x4*)(vsrc + (size_t)t * 64 * NP); }
    if (t + 1 < NT) { st.k1 = *(const u32x4*)(ksrc + (size_t)(t + 1) * 64 * NP); st.v1 = *(const u32x4*)(vsrc + (size_t)(t + 1) * 64 * NP); }
}
__device__ __forceinline__ void kv_store(const KVStage& st, LAS unsigned char* lds, int kdst, int vdst, int slot, int t, int NT) {
    if (t < NT) { *(LAS u32x4*)(lds + kdst + slot * 2 * KSUB) = st.k0; *(LAS u32x4*)(lds + vdst + slot * 16384) = st.v0; }
    if (t + 1 < NT) { *(LAS u32x4*)(lds + kdst + slot * 2 * KSUB + KSUB) = st.k1; *(LAS u32x4*)(lds + vdst + slot * 16384 + 8192) = st.v1; }
}
__device__ __forceinline__ bool attn_period(int p, int NT, LAS unsigned char* lds, const bf16* ksrc, const bf16* vsrc, int kdst, int vdst, const LAS float* cbl, LAS float* wsf, const bf16x8* qr,
                                            int qpos, const LAS unsigned char* vb0, int r32, int hi, int wid, float qbound, float& m_run, float& l_run, f32x16* o, KVStage& sw, KVStage& sl) {
    const int cur = p & 1, t = 2 * p;
    if (p >= 2) kv_load(sl, ksrc, vsrc, t - 4, NT);
    const int qlast = (qpos | 31);
    if (t + 1 < NT && (t + 1) * 64 <= qlast) attn_sub(t + 1, NT, lds + AL_K + cur * 2 * KSUB + KSUB, vb0 + cur * 16384 + 8192, cbl, wsf, qr, qpos, r32, hi, m_run, l_run, o);
    if (t * 64 <= qlast) attn_sub(t, NT, lds + AL_K + cur * 2 * KSUB, vb0 + cur * 16384, cbl, wsf, qr, qpos, r32, hi, m_run, l_run, o);
    LAS unsigned* stopf = (LAS unsigned*)(lds + AL_STOP) + cur * 8;
    { const bool done = (p > 0) && __all(qbound + cbl[t * 64 - 1] - m_run < -160.f); if ((r32 | hi) == 0) stopf[wid] = done ? 1u : 0u; }
    if (p >= 2) asm volatile("s_waitcnt vmcnt(4)" ::: "memory"); else asm volatile("s_waitcnt vmcnt(0)" ::: "memory");
    if (p >= 1) kv_store(sw, lds, kdst, vdst, cur ^ 1, t - 2, NT);
    BAR_LDS();
    const u32x4 f0 = *(const LAS u32x4*)stopf, f1 = *(const LAS u32x4*)(stopf + 4);
    return (f0.x & f0.y & f0.z & f0.w & f1.x & f1.y & f1.z & f1.w) != 0u;
}

__device__ __forceinline__ void attn_unit(const Prm& P, int bh, int qb, LAS unsigned char* lds) {
    const int tid = opaque_tid(), lane = tid & 63, r32 = lane & 31, hi = lane >> 5; const int wid = __builtin_amdgcn_readfirstlane(tid >> 6);
    const int b = bh >> 3, h = bh & 7;
    const int q0 = 64 + 256 * qb, NT = (q0 + 256) / 64;
    const bf16* Pb = (const bf16*)(P.ws + WS_P) + (size_t)b * LP * NP;
    LAS float* cbl = (LAS float*)(lds + AL_CB); LAS float* wsf = (LAS float*)(lds + AL_WSF) + wid * 64;
    { const float* CB = (const float*)(P.ws + WS_CB) + (size_t)bh * LP; const int lim = q0 + 256; f32x4 cv[3];
#pragma unroll
      for (int i = 0; i < 3; ++i) { const int k = 4 * tid + 2048 * i; cv[i] = *(const f32x4*)(CB + (k < lim ? k : 0)); }
#pragma unroll
      for (int i = 0; i < 3; ++i) { const int k = 4 * tid + 2048 * i; if (k < lim) *(LAS f32x4*)(cbl + k) = cv[i]; } }
    const int krow = tid >> 3, kch = tid & 7;
    const bf16* ksrc = Pb + (size_t)krow * NP + PC_K + h * 64 + kch * 8; const int kdst = AL_K + kch * KCH + krow * 16;
    const int vrow = 16 * (wid & 3) + (lane >> 2), vd = 32 * (wid >> 2) + (lane & 3) * 8;
    const bf16* vsrc = Pb + (size_t)vrow * NP + PC_V + h * 64 + vd; const int vdst = AL_V + wid * 1024 + lane * 16;
    KVStage sA, sB;
    const int NPER = (NT + 1) / 2;
    kv_load(sB, ksrc, vsrc, 2 * (NPER - 1), NT); kv_load(sA, ksrc, vsrc, 2 * (NPER - 2), NT);
    const int qpos = q0 + wid * 32 + r32;
    const bf16* Qw = Pb + (size_t)qpos * NP + PC_Q + h * 64;
    bf16x8 qr[4];
#pragma unroll
    for (int d0 = 0; d0 < 4; ++d0) qr[d0] = *(const bf16x8*)(Qw + d0 * 16 + hi * 8);
    kv_store(sB, lds, kdst, vdst, (NPER - 1) & 1, 2 * (NPER - 1), NT);
    __syncthreads();
    const LAS unsigned char* vb0 = lds + AL_V + ((lane >> 4) & 1) * 32 + (lane & 3) * 8 + (4 * hi + ((lane & 15) >> 2)) * 64;
    float m_run = 0.f, l_run = 0.f; f32x16 o[2];
    o[0] = f32x16{}; o[1] = f32x16{};
    asm volatile("" : "+v"(qr[0]), "+v"(qr[1]), "+v"(qr[2]), "+v"(qr[3]));
    float qbound;
    { float sq = 0.f;
#pragma unroll
      for (int d0 = 0; d0 < 4; ++d0)
#pragma unroll
          for (int e = 0; e < 8; ++e) { const float v = __builtin_bit_cast(float, (unsigned)(unsigned short)qr[d0][e] << 16); sq += v * v; }
      auto rr = __builtin_amdgcn_permlane32_swap(__float_as_uint(sq), __float_as_uint(sq), false, false); sq = __uint_as_float(rr[0]) + __uint_as_float(rr[1]);
      qbound = sqrtf(sq) * ((const float*)(P.ws + WS_KMAX))[bh] * 1.02f + 1.f; }
    for (int p = NPER - 1; p >= 0; p -= 2) {
        if (attn_period(p, NT, lds, ksrc, vsrc, kdst, vdst, cbl, wsf, qr, qpos, vb0, r32, hi, wid, qbound, m_run, l_run, o, sA, sB)) break;
        if (p >= 1 && attn_period(p - 1, NT, lds, ksrc, vsrc, kdst, vdst, cbl, wsf, qr, qpos, vb0, r32, hi, wid, qbound, m_run, l_run, o, sB, sA)) break;
    }
    const float l_tot = l_run + __shfl_xor(l_run, 32);
    if (hi == 0) wsf[32 + r32] = l_tot;
    LDSWAIT();
    bf16* mix = (bf16*)(P.ws + WS_MIX);
    { LAS float* stg = (LAS float*)(lds + wid * 8192);
      const int erow = lane >> 1, eh = lane & 1; const int epos = q0 + wid * 32 + erow;
      const bf16* zr = Pb + (size_t)epos * NP + PC_ZF + h * 64 + eh * 32;
      u32x4 zw[4];
#pragma unroll
      for (int i = 0; i < 4; ++i) zw[i] = *(const u32x4*)(zr + 8 * i);
#pragma unroll
      for (int r = 0; r < 16; ++r) { const int q = crow(r, hi); const float rl = __builtin_amdgcn_rcpf(wsf[32 + q]);
#pragma unroll
          for (int d0 = 0; d0 < 2; ++d0) stg[q * 64 + d0 * 32 + r32] = o[d0][r] * rl; }
      LDSWAIT();
      bf16* mr = mix + ((size_t)b * SEQ + (epos - 64)) * DM + h * 64 + eh * 32;
#pragma unroll
      for (int i = 0; i < 4; ++i) { float zf[8], ov[8]; unpack8(zw[i], zf); { const f32x4 a = *(const LAS f32x4*)(stg + erow * 64 + eh * 32 + 8 * i), c = *(const LAS f32x4*)(stg + erow * 64 + eh * 32 + 8 * i + 4); ov[0] = a[0]; ov[1] = a[1]; ov[2] = a[2]; ov[3] = a[3]; ov[4] = c[0]; ov[5] = c[1]; ov[6] = c[2]; ov[7] = c[3]; }
#pragma unroll
          for (int e = 0; e < 8; ++e) ov[e] = ov[e] * zf[e] * sigmoidf_(zf[e]);
          *(u32x4*)(mr + 8 * i) = (u32x4){cvtpk(ov[0], ov[1]), cvtpk(ov[2], ov[3]), cvtpk(ov[4], ov[5]), cvtpk(ov[6], ov[7])}; } }
    __syncthreads();
}

__device__ __forceinline__ void kmax_job(const Prm& P, int bh, LAS unsigned char* lds) {
    const int tid = opaque_tid(), b = bh >> 3, h = bh & 7;
    const bf16* Kb = (const bf16*)(P.ws + WS_P) + (size_t)b * LP * NP + PC_K + h * 64 + (tid & 7) * 8;
    LAS unsigned* mx = (LAS unsigned*)lds;
    if (tid == 0) *mx = 0u;
    __syncthreads();
    float best = 0.f;
    for (int r0 = 0; r0 < LP; r0 += 64 * 5) {
        u32x4 w[5];
#pragma unroll
        for (int i = 0; i < 5; ++i) w[i] = *(const u32x4*)(Kb + (size_t)(r0 + 64 * i + (tid >> 3)) * NP);
#pragma unroll
        for (int i = 0; i < 5; ++i) { float f[8]; unpack8(w[i], f); float sq = 0.f;
#pragma unroll
            for (int e = 0; e < 8; ++e) sq += f[e] * f[e];
            best = fmaxf(best, reduce8(sq)); }
    }
    __hip_atomic_fetch_max(mx, __float_as_uint(best), __ATOMIC_RELAXED, __HIP_MEMORY_SCOPE_WORKGROUP);
    __syncthreads();
    if (tid == 0) ((float*)(P.ws + WS_KMAX))[bh] = sqrtf(__uint_as_float(*mx));
    __syncthreads();
}

constexpr float GN_EPS = 64e-5f;
constexpr int NCHUNK = LP / 64;
constexpr int MS = 72;
constexpr int MB = 64 * MS * 2;
constexpr int PA_ACTW = 0, PA_ACTA = 8192;
constexpr int PA_AAB = 0, PA_AAK = MB, PA_ARB = 2 * MB, PA_ARK = 3 * MB;
constexpr int PA_L = 36864;
constexpr int PA_AABF = PA_L, PA_T = PA_L + 16384, PA_T11T = PA_L + 16384 + MB;
constexpr int PA_SEG = 69632, PA_TOT = PA_SEG + 2048, PA_OP = 72192;
constexpr int PA_AT = PA_OP, PA_BT = PA_OP + MB, PA_KT = PA_OP + 2 * MB, PA_RT = PA_OP + 3 * MB, PA_ATT = PA_OP + 4 * MB, PA_BHT = PA_OP + 5 * MB, PA_KHT = PA_OP + 6 * MB, PA_VT = PA_OP + 7 * MB;
constexpr int PA_AVT = PA_AT, PA_UAT = PA_BT, PA_UVT = PA_KT, PA_M2T = PA_KT;
constexpr int PA_WUPT = 147456, PA_AUPT = 155648;
static_assert(PA_OP + 8 * MB <= 146432 && PA_AUPT + 8192 <= LDS_BYTES, "pass A LDS map");
constexpr size_t WS_G = 16 * MiB, WS_Q = 16 * MiB + (size_t)NB * 8 * NCHUNK * 8192, WS_BON = 358 * MiB + 512 * 1024, WS_HV = 424 * MiB;
static_assert(WS_Q + (size_t)NB * 8 * NCHUNK * 8192 <= 82 * MiB && WS_HV + (size_t)NB * 8 * NCHUNK * 16384 <= 512 * MiB, "ws map");

__device__ __forceinline__ void load8(const float* p, float* f) { const f32x4 a = *(const f32x4*)p, b = *(const f32x4*)(p + 4); f[0] = a[0]; f[1] = a[1]; f[2] = a[2]; f[3] = a[3]; f[4] = b[0]; f[5] = b[1]; f[6] = b[2]; f[7] = b[3]; }
__device__ __forceinline__ void lload8(const LAS float* p, float* f) { const f32x4 a = *(const LAS f32x4*)p, b = *(const LAS f32x4*)(p + 4); f[0] = a[0]; f[1] = a[1]; f[2] = a[2]; f[3] = a[3]; f[4] = b[0]; f[5] = b[1]; f[6] = b[2]; f[7] = b[3]; }
__device__ __forceinline__ void shift8(const bf16* cur, const bf16* prev, bool has_prev, const float* mu, float* out) {
    float c[8], p[8], m[8];
    const u32x4 cw = *(const u32x4*)cur; u32x4 pw = *(const u32x4*)(has_prev ? prev : cur);
    load8(mu, m);
    if (!has_prev) pw = (u32x4){0u, 0u, 0u, 0u};
    unpack8(cw, c); unpack8(pw, p);
#pragma unroll
    for (int i = 0; i < 8; ++i) out[i] = c[i] + m[i] * (p[i] - c[i]);
}
__device__ __forceinline__ float ldbf(const bf16* p) { return __builtin_bit_cast(float, (unsigned)(*p) << 16); }
template <int KS> __device__ __forceinline__ f32x16 mm_tile(const LAS unsigned char* a, const LAS unsigned char* b, f32x16 acc, int r32, int hi) {
#pragma unroll
    for (int ks = 0; ks < KS; ++ks) { const bf16x8 af = *(const LAS bf16x8*)(a + (r32 * MS + hi * 8 + ks * 16) * 2), bfr = *(const LAS bf16x8*)(b + (r32 * MS + hi * 8 + ks * 16) * 2);
        acc = __builtin_amdgcn_mfma_f32_32x32x16_bf16(af, bfr, acc, 0, 0, 0); }
    return acc;
}
__device__ __forceinline__ void st_rm(LAS unsigned char* d, const f32x16& acc, int r32, int hi) {
#pragma unroll
    for (int r = 0; r < 16; r += 2) { const unsigned w = cvtpk(acc[r], acc[r + 1]); *(LAS bf16*)(d + (crow(r, hi) * MS + r32) * 2) = (bf16)(w & 0xffffu); *(LAS bf16*)(d + (crow(r + 1, hi) * MS + r32) * 2) = (bf16)(w >> 16); }
}
__device__ __forceinline__ void st_tr(LAS unsigned char* d, const f32x16& acc, int r32, int hi) {
#pragma unroll
    for (int g = 0; g < 4; ++g) { const unsigned long long w = (unsigned long long)cvtpk(acc[4 * g], acc[4 * g + 1]) | ((unsigned long long)cvtpk(acc[4 * g + 2], acc[4 * g + 3]) << 32);
        *(LAS unsigned long long*)(d + (r32 * MS + 8 * g + 4 * hi) * 2) = w; }
}

struct PAPre { u32x4 cwd, cad, pwd, pad; unsigned gr[9], gk[9], gv[9]; };
__device__ __forceinline__ void pa_prefetch(const Prm& P, int unit, PAPre& pf, int tid, int lane, int wid) {
    const int bh = unit / NCHUNK, ck = unit % NCHUNK, b = bh >> 3, h = bh & 7;
    const bf16* Pb = (const bf16*)(P.ws + WS_P) + (size_t)b * LP * NP;
    { const int tt = tid >> 3, cg = tid & 7; const int t = ck * 64 + tt; const bf16* prow = Pb + (size_t)t * NP; const bf16* qrow = t > 0 ? prow - NP : prow;
      pf.cwd = *(const u32x4*)(prow + PC_WD + cg * 8); pf.cad = *(const u32x4*)(prow + PC_AD + cg * 8);
      pf.pwd = *(const u32x4*)(qrow + PC_WD + cg * 8); pf.pad = *(const u32x4*)(qrow + PC_AD + cg * 8); }
    { const int hc_ = h * 64 + lane, t0_ = ck * 64 + 8 * wid;
#pragma unroll
      for (int i = 0; i < 9; ++i) { const int t_ = t0_ - 1 + i; const bf16* q = Pb + (size_t)(t_ < 0 ? 0 : t_) * NP + hc_; pf.gr[i] = q[PC_R]; pf.gk[i] = q[PC_RK]; pf.gv[i] = q[PC_RV]; } }
}

__device__ __forceinline__ void rwkv_pass_a(const Prm& P, int unit, LAS unsigned char* lds, int& cur_head, PAPre& pf, int next_unit) {
    const int tid = opaque_tid(), lane = tid & 63, r32 = lane & 31, hi = lane >> 5; const int wid = __builtin_amdgcn_readfirstlane(tid >> 6);
    const int bh = unit / NCHUNK, ck = unit % NCHUNK, b = bh >> 3, h = bh & 7;
    const bf16* Pb = (const bf16*)(P.ws + WS_P) + (size_t)b * LP * NP;
    unsigned gr[9], gk[9], gv[9];
#pragma unroll
    for (int i = 0; i < 9; ++i) { gr[i] = pf.gr[i]; gk[i] = pf.gk[i]; gv[i] = pf.gv[i]; }
    if (ck * 64 + 8 * wid == 0) { gr[0] = 0u; gk[0] = 0u; gv[0] = 0u; }
    if (h != cur_head) { cur_head = h; const int c = tid & 63, jg = tid >> 6; float w[8], a[8];
#pragma unroll
        for (int i = 0; i < 8; ++i) { w[i] = P.w_up[(size_t)(jg * 8 + i) * 512 + h * 64 + c]; a[i] = P.a_up[(size_t)(jg * 8 + i) * 512 + h * 64 + c]; }
        *(LAS u32x4*)(lds + PA_WUPT + (c * 64 + jg * 8) * 2) = (u32x4){pk2(w[0], w[1]), pk2(w[2], w[3]), pk2(w[4], w[5]), pk2(w[6], w[7])};
        *(LAS u32x4*)(lds + PA_AUPT + (c * 64 + jg * 8) * 2) = (u32x4){pk2(a[0], a[1]), pk2(a[2], a[3]), pk2(a[4], a[5]), pk2(a[6], a[7])}; }
    { const int tt = tid >> 3, cg = tid & 7; const int t = ck * 64 + tt; const bool hp = t > 0;
      float xs[8], ys[8];
      const u32x4 cwd = pf.cwd, cad = pf.cad; u32x4 pwd = pf.pwd, pad = pf.pad;
      float mw[8], ma[8]; load8(P.mu + 1536 + cg * 8, mw); load8(P.mu + 1600 + cg * 8, ma);
      if (!hp) { pwd = (u32x4){0u, 0u, 0u, 0u}; pad = pwd; }
      { float c[8], p[8]; unpack8(cwd, c); unpack8(pwd, p);
#pragma unroll
        for (int i = 0; i < 8; ++i) xs[i] = ftanh(c[i] + mw[i] * (p[i] - c[i]));
        unpack8(cad, c); unpack8(pad, p);
#pragma unroll
        for (int i = 0; i < 8; ++i) ys[i] = c[i] + ma[i] * (p[i] - c[i]); }
      *(LAS u32x4*)(lds + PA_ACTW + (tt * 64 + cg * 8) * 2) = (u32x4){cvtpk(xs[0], xs[1]), cvtpk(xs[2], xs[3]), cvtpk(xs[4], xs[5]), cvtpk(xs[6], xs[7])};
      *(LAS u32x4*)(lds + PA_ACTA + (tt * 64 + cg * 8) * 2) = (u32x4){cvtpk(ys[0], ys[1]), cvtpk(ys[2], ys[3]), cvtpk(ys[4], ys[5]), cvtpk(ys[6], ys[7])}; }
    __syncthreads();
    { const int sel = wid >> 2, tm = (wid >> 1) & 1, tn = wid & 1;
      const LAS unsigned char* act = lds + (sel ? PA_ACTA : PA_ACTW) + ((32 * tm + r32) * 64 + hi * 8) * 2;
      const LAS unsigned char* wt = lds + (sel ? PA_AUPT : PA_WUPT) + ((32 * tn + r32) * 64 + hi * 8) * 2;
      f32x16 acc = {};
#pragma unroll
      for (int ks = 0; ks < 4; ++ks) { const bf16x8 af = *(const LAS bf16x8*)(act + ks * 32), bfr = *(const LAS bf16x8*)(wt + ks * 32); acc = __builtin_amdgcn_mfma_f32_32x32x16_bf16(af, bfr, acc, 0, 0, 0); }
      LAS float* lo = (LAS float*)(lds + PA_L + sel * 16384);
#pragma unroll
      for (int r = 0; r < 16; ++r) lo[(32 * tm + crow(r, hi)) * 64 + 32 * tn + r32] = acc[r]; }
    __syncthreads();
    {
        const int c = lane, hc = h * 64 + c, t0 = ck * 64 + 8 * wid;
        const float mu_r = P.mu[hc], mu_k = P.mu[512 + hc], mu_v = P.mu[1024 + hc], w0c = P.w0[hc], a0c = P.a0[hc], kkc = P.k_k[hc], kac = P.k_a[hc], rkc = P.r_k[hc];
        float pr = __builtin_bit_cast(float, (unsigned)gr[0] << 16), pk = __builtin_bit_cast(float, (unsigned)gk[0] << 16), pv_ = __builtin_bit_cast(float, (unsigned)gv[0] << 16);
        float lw[8], cum[8], rr[8], k2[8], vv[8], av[8], bv[8];
        float run = 0.f;
        float* bong = (float*)(P.ws + WS_BON) + (size_t)unit * 64;
#pragma unroll
        for (int i = 0; i < 8; ++i) {
            const float cr = __builtin_bit_cast(float, (unsigned)gr[i + 1] << 16), ckk = __builtin_bit_cast(float, (unsigned)gk[i + 1] << 16), cv = __builtin_bit_cast(float, (unsigned)gv[i + 1] << 16);
            rr[i] = cr + mu_r * (pr - cr); const float kx = ckk + mu_k * (pk - ckk); vv[i] = cv + mu_v * (pv_ - cv); pr = cr; pk = ckk; pv_ = cv;
            const float xw = ((const LAS float*)(lds + PA_L))[(8 * wid + i) * 64 + c] + w0c, xa = ((const LAS float*)(lds + PA_L + 16384))[(8 * wid + i) * 64 + c] + a0c;
            const float nx = -xw; const float sp = fmaxf(nx, 0.f) + flog1pexp_neg(fabsf(nx));
            lw[i] = -fexp(-sp - 0.5f); run += lw[i]; cum[i] = run;
            const float alpha = sigmoidf_(xa);
            float kn = kx * kkc; const float ss = wave_sum_dpp(kn * kn); kn *= __builtin_amdgcn_rsqf(ss + 1e-12f);
            k2[i] = kx * (1.f + (alpha - 1.f) * kac); av[i] = -kn; bv[i] = kn * alpha;
            const float bon = wave_sum_dpp(rr[i] * k2[i] * rkc);
            if (lane == 0) bong[8 * wid + i] = bon;
        }
        ((LAS float*)(lds + PA_SEG))[wid * 64 + c] = run;
        if (next_unit >= 0) pa_prefetch(P, next_unit, pf, tid, lane, wid);
        __syncthreads();
        float pre = 0.f, tot = 0.f;
#pragma unroll
        for (int g = 0; g < 8; ++g) { const float sgv = ((const LAS float*)(lds + PA_SEG))[g * 64 + c]; tot += sgv; if (g < wid) pre += sgv; }
        if (wid == 0) ((LAS float*)(lds + PA_TOT))[c] = tot;
        unsigned att[4], bht[4], kht[4], vt[4]; float tA[8], tB[8], tK[8];
#pragma unroll
        for (int i = 0; i < 8; ++i) {
            const float cm = pre + cum[i]; const float e2 = fexp(cm), e1 = fexp(cm - lw[i]), e3 = fexp(-cm), e4 = fexp(tot - cm);
            const int row = 8 * wid + i;
            tA[i] = av[i] * e1; tB[i] = bv[i] * e4; tK[i] = k2[i] * e4;
            const unsigned w0_ = cvtpk(tA[i], rr[i] * e2), w1_ = cvtpk(bv[i] * e3, k2[i] * e3);
            *(LAS bf16*)(lds + PA_AT + (row * MS + c) * 2) = (bf16)(w0_ & 0xffffu);
            *(LAS bf16*)(lds + PA_RT + (row * MS + c) * 2) = (bf16)(w0_ >> 16);
            *(LAS bf16*)(lds + PA_BT + (row * MS + c) * 2) = (bf16)(w1_ & 0xffffu);
            *(LAS bf16*)(lds + PA_KT + (row * MS + c) * 2) = (bf16)(w1_ >> 16);
        }
#pragma unroll
        for (int i = 0; i < 4; ++i) { att[i] = cvtpk(tA[2 * i], tA[2 * i + 1]); bht[i] = cvtpk(tB[2 * i], tB[2 * i + 1]); kht[i] = cvtpk(tK[2 * i], tK[2 * i + 1]); vt[i] = cvtpk(vv[2 * i], vv[2 * i + 1]); }
        *(LAS u32x4*)(lds + PA_ATT + (c * MS + 8 * wid) * 2) = (u32x4){att[0], att[1], att[2], att[3]};
        *(LAS u32x4*)(lds + PA_BHT + (c * MS + 8 * wid) * 2) = (u32x4){bht[0], bht[1], bht[2], bht[3]};
        *(LAS u32x4*)(lds + PA_KHT + (c * MS + 8 * wid) * 2) = (u32x4){kht[0], kht[1], kht[2], kht[3]};
        *(LAS u32x4*)(lds + PA_VT + (c * MS + 8 * wid) * 2) = (u32x4){vt[0], vt[1], vt[2], vt[3]};
    }
    __syncthreads();
    {
        const int mat = wid >> 1;
        const LAS unsigned char* Am = lds + ((mat & 2) ? PA_RT : PA_AT); const LAS unsigned char* Bm = lds + ((mat & 1) ? PA_KT : PA_BT);
        LAS unsigned char* D = lds + PA_AAB + mat * MB; const bool strict = mat < 2;
        if ((wid & 1) == 0) {
#pragma unroll
            for (int d = 0; d < 2; ++d) {
                f32x16 acc = {}; acc = mm_tile<4>(Am + d * 32 * MS * 2, Bm + d * 32 * MS * 2, acc, r32, hi);
#pragma unroll
                for (int r = 0; r < 16; ++r) { const int tl = crow(r, hi); const bool keep = strict ? (r32 < tl) : (r32 <= tl); acc[r] = keep ? acc[r] : 0.f; }
                st_rm(D + (d * 32 * MS + d * 32) * 2, acc, r32, hi);
                if (mat == 0) {
#pragma unroll
                    for (int r = 0; r < 16; ++r) ((LAS float*)(lds + PA_AABF))[(d * 32 + crow(r, hi)) * 64 + d * 32 + r32] = acc[r]; }
            }
        } else {
            f32x16 acc = {}; acc = mm_tile<4>(Am + 32 * MS * 2, Bm, acc, r32, hi);
            st_rm(D + (32 * MS) * 2, acc, r32, hi);
            f32x16 z = {}; st_rm(D + 32 * 2, z, r32, hi);
        }
    }
    __syncthreads();
    f32x16 yl = {}, hv = {};
    const int tm4 = (wid >> 1) & 1, tn4 = wid & 1;
    if (wid == 0) {
        const int blk = hi, c = r32; float T[32]; int offs[34];
        const LAS float* Ab = (const LAS float*)(lds + PA_AABF) + (blk * 32) * 64 + blk * 32;
        offs[0] = 0; offs[1] = 64;
#pragma unroll
        for (int t = 0; t < 32; ++t) {
            float ac4[4] = {(t == c) ? 1.f : 0.f, 0.f, 0.f, 0.f};
            const LAS float* Ar = Ab + offs[t];
#pragma unroll
            for (int s4 = 0; s4 < (t + 3) / 4; ++s4) { const f32x4 a4 = *(const LAS f32x4*)(Ar + 4 * s4);
#pragma unroll
                for (int e = 0; e < 4; ++e) if (4 * s4 + e < t) ac4[e] += a4[e] * T[4 * s4 + e]; }
            T[t] = (ac4[0] + ac4[1]) + (ac4[2] + ac4[3]);
            int ro = (t + 2) * 64; asm volatile("" : "+v"(ro), "+v"(T[t]));
            offs[t + 2] = ro;
        }
        LAS unsigned char* Td = lds + PA_T;
#pragma unroll
        for (int t = 0; t < 32; ++t) { *(LAS bf16*)(Td + ((blk * 32 + t) * MS + blk * 32 + c) * 2) = (bf16)f2bf(T[t]); if (blk == 0) *(LAS bf16*)(Td + (t * MS + 32 + c) * 2) = 0; }
        if (blk == 0) {
#pragma unroll
            for (int g = 0; g < 4; ++g) *(LAS u32x4*)(lds + PA_T11T + (c * MS + 8 * g) * 2) = (u32x4){pk2(T[8 * g], T[8 * g + 1]), pk2(T[8 * g + 2], T[8 * g + 3]), pk2(T[8 * g + 4], T[8 * g + 5]), pk2(T[8 * g + 6], T[8 * g + 7])}; }
    } else if (wid >= 4) {
        const LAS unsigned char* Vb = lds + PA_VT + tn4 * 32 * MS * 2;
        f32x16 av_ = {}; av_ = mm_tile<4>(lds + PA_AAK + tm4 * 32 * MS * 2, Vb, av_, r32, hi);
        yl = mm_tile<4>(lds + PA_ARK + tm4 * 32 * MS * 2, Vb, yl, r32, hi);
        hv = mm_tile<4>(lds + PA_KHT + tm4 * 32 * MS * 2, Vb, hv, r32, hi);
        st_tr(lds + PA_AVT + (tn4 * 32 * MS + tm4 * 32) * 2, av_, r32, hi);
    }
    __syncthreads();
    if (wid == 0) { f32x16 acc = {}; acc = mm_tile<2>(lds + PA_AAB + 32 * MS * 2, lds + PA_T11T, acc, r32, hi); st_tr(lds + PA_M2T, acc, r32, hi); }
    __syncthreads();
    if (wid == 0) { f32x16 acc = {}; acc = mm_tile<2>(lds + PA_T + (32 * MS + 32) * 2, lds + PA_M2T, acc, r32, hi); st_rm(lds + PA_T + (32 * MS) * 2, acc, r32, hi); }
    __syncthreads();
    { f32x16 acc = {}; const LAS unsigned char* Bsrc = lds + (wid < 4 ? PA_ATT : PA_AVT) + tn4 * 32 * MS * 2;
      acc = mm_tile<4>(lds + PA_T + tm4 * 32 * MS * 2, Bsrc, acc, r32, hi);
      __syncthreads();
      st_tr(lds + (wid < 4 ? PA_UAT : PA_UVT) + (tn4 * 32 * MS + tm4 * 32) * 2, acc, r32, hi); }
    __syncthreads();
    if (wid < 4) {
        const LAS unsigned char* Ub = lds + PA_UAT + tn4 * 32 * MS * 2;
        f32x16 q = {}; q = mm_tile<4>(lds + PA_ARB + tm4 * 32 * MS * 2, Ub, q, r32, hi);
        f32x16 g = {}; g = mm_tile<4>(lds + PA_BHT + tm4 * 32 * MS * 2, Ub, g, r32, hi);
        bf16* Qg = (bf16*)(P.ws + WS_Q) + (size_t)unit * 4096; bf16* Gg = (bf16*)(P.ws + WS_G) + (size_t)unit * 4096;
        const float pc = __expf(((const LAS float*)(lds + PA_TOT))[tn4 * 32 + r32]);
#pragma unroll
        for (int r = 0; r < 16; ++r) { const int row = tm4 * 32 + crow(r, hi), col = tn4 * 32 + r32;
            const float rt = __builtin_bit_cast(float, (unsigned)(*(const LAS bf16*)(lds + PA_RT + (row * MS + col) * 2)) << 16);
            const unsigned w = cvtpk(q[r] + rt, g[r] + (row == col ? pc : 0.f)); Qg[row * 64 + col] = (bf16)(w & 0xffffu); Gg[row * 64 + col] = (bf16)(w >> 16); }
    } else {
        const LAS unsigned char* Ub = lds + PA_UVT + tn4 * 32 * MS * 2;
        yl = mm_tile<4>(lds + PA_ARB + tm4 * 32 * MS * 2, Ub, yl, r32, hi);
        hv = mm_tile<4>(lds + PA_BHT + tm4 * 32 * MS * 2, Ub, hv, r32, hi);
        float* HVg = (float*)(P.ws + WS_HV) + (size_t)unit * 4096 + ((wid & 3) * 64 + lane) * 16;
#pragma unroll
        for (int g = 0; g < 4; ++g) *(f32x4*)(HVg + 4 * g) = (f32x4){hv[4 * g], hv[4 * g + 1], hv[4 * g + 2], hv[4 * g + 3]};
        if (ck >= 1) { bf16* mix = (bf16*)(P.ws + WS_MIX) + ((size_t)b * SEQ + (ck * 64 - 64)) * DM + 512 + h * 64;
#pragma unroll
            for (int r = 0; r < 16; r += 2) { const unsigned w = cvtpk(yl[r], yl[r + 1]); mix[(size_t)(tm4 * 32 + crow(r, hi)) * DM + tn4 * 32 + r32] = (bf16)(w & 0xffffu); mix[(size_t)(tm4 * 32 + crow(r + 1, hi)) * DM + tn4 * 32 + r32] = (bf16)(w >> 16); } }
    }
    __syncthreads();
}

constexpr int PB_S0 = 0, PB_S1 = MB, PB_Y = 2 * MB;
__device__ __forceinline__ void rwkv_pass_b(const Prm& P, int bh, LAS unsigned char* lds) {
    const int tid = opaque_tid(), lane = tid & 63, r32 = lane & 31, hi = lane >> 5; const int wid = __builtin_amdgcn_readfirstlane(tid >> 6);
    const int b = bh >> 3, h = bh & 7;
    const bf16* Pb = (const bf16*)(P.ws + WS_P) + (size_t)b * LP * NP;
    bf16* mix = (bf16*)(P.ws + WS_MIX);
    const int tm = (wid >> 1) & 1, tn = wid & 1;
    const int tt = tid >> 3, cg = tid & 7, hc = h * 64 + cg * 8;
    for (int i = tid; i < 2 * MB / 4; i += NTHR) ((LAS unsigned*)(lds + PB_S0))[i] = 0u;
    float gw[8], gb[8], muv[8];
    load8(P.gn_w + hc, gw); load8(P.gn_b + hc, gb); load8(P.mu + 1024 + hc, muv);
    const bf16* Abase = (const bf16*)(P.ws + (wid < 4 ? WS_G : WS_Q)) + (size_t)bh * NCHUNK * 4096 + (tm * 32 + r32) * 64 + hi * 8;
    const float* HVbase = (const float*)(P.ws + WS_HV) + (size_t)bh * NCHUNK * 4096 + ((wid & 3) * 64 + lane) * 16;
    const float* BONbase = (const float*)(P.ws + WS_BON) + (size_t)bh * NCHUNK * 64 + tt;
    bf16x8 afA[4], afB[4]; f32x4 ciA[4], ciB[4];
#define PB_LOAD(af_, ci_, ck_) do { const bf16* ag_ = Abase + (size_t)(ck_) * 4096; \
        _Pragma("unroll") for (int ks = 0; ks < 4; ++ks) af_[ks] = *(const bf16x8*)(ag_ + ks * 16); \
        if (wid < 4) { const float* hv_ = HVbase + (size_t)(ck_) * 4096; _Pragma("unroll") for (int g = 0; g < 4; ++g) ci_[g] = *(const f32x4*)(hv_ + 4 * g); } \
        else { _Pragma("unroll") for (int g = 0; g < 4; ++g) ci_[g] = (f32x4){0.f, 0.f, 0.f, 0.f}; } } while (0)
#pragma unroll
    for (int i = 0; i < 8; ++i) asm volatile("" : "+v"(gw[i]), "+v"(gb[i]), "+v"(muv[i]));
    PB_LOAD(afA, ciA, 0); PB_LOAD(afB, ciB, 1);
    u32x4 eyl = {}, evc = {}, evp = {}, ez = {}; float ebon = 0.f;
#define PB_ELOAD(ck_) do { const int t_ = (ck_) * 64 + tt; const bf16* pr_ = Pb + (size_t)t_ * NP; \
        eyl = *(const u32x4*)(mix + ((size_t)b * SEQ + (t_ - 64)) * DM + 512 + hc); evc = *(const u32x4*)(pr_ + PC_RV + hc); evp = *(const u32x4*)(pr_ - NP + PC_RV + hc); \
        ez = *(const u32x4*)(pr_ + PC_ZR + hc); ebon = BONbase[(size_t)(ck_) * 64]; } while (0)
    __syncthreads();
    for (int ck = 0; ck < NCHUNK; ++ck) {
        const int cur = ck & 1;
        const LAS unsigned char* Sb = lds + (cur ? PB_S1 : PB_S0) + (tn * 32 * MS) * 2;
        f32x16 acc;
#pragma unroll
        for (int g = 0; g < 4; ++g) { acc[4 * g] = ciA[g][0]; acc[4 * g + 1] = ciA[g][1]; acc[4 * g + 2] = ciA[g][2]; acc[4 * g + 3] = ciA[g][3]; }
#pragma unroll
        for (int ks = 0; ks < 4; ++ks) { const bf16x8 bfr = *(const LAS bf16x8*)(Sb + (r32 * MS + hi * 8 + ks * 16) * 2);
            acc = __builtin_amdgcn_mfma_f32_32x32x16_bf16(afA[ks], bfr, acc, 0, 0, 0); }
#pragma unroll
        for (int ks = 0; ks < 4; ++ks) { afA[ks] = afB[ks]; ciA[ks] = ciB[ks]; }
        if (ck + 2 < NCHUNK) PB_LOAD(afB, ciB, ck + 2);
        const u32x4 cyl = eyl, cvc = evc, cvp = evp, cz = ez; const float cbon = ebon;
        if (ck + 1 < NCHUNK) PB_ELOAD(ck + 1);
        if (wid < 4) st_tr(lds + (cur ? PB_S0 : PB_S1) + (tn * 32 * MS + tm * 32) * 2, acc, r32, hi);
        else {
#pragma unroll
            for (int r = 0; r < 16; ++r) ((LAS float*)(lds + PB_Y))[(tm * 32 + crow(r, hi)) * 64 + tn * 32 + r32] = acc[r]; }
        BAR_LDS();
        if (ck >= 1) {
            const int t = ck * 64 + tt;
            bf16* mrow = mix + ((size_t)b * SEQ + (t - 64)) * DM + 512 + hc;
            float y8[8], yl8[8], vc[8], vp[8], z8[8];
            lload8((const LAS float*)(lds + PB_Y) + tt * 64 + cg * 8, y8); unpack8(cyl, yl8); unpack8(cvc, vc); unpack8(cvp, vp); unpack8(cz, z8);
            float sm = 0.f;
#pragma unroll
            for (int i = 0; i < 8; ++i) { y8[i] += yl8[i]; sm += y8[i]; }
            const float mean = reduce8(sm) * (1.f / 64.f); float sq = 0.f;
#pragma unroll
            for (int i = 0; i < 8; ++i) { const float d = y8[i] - mean; sq += d * d; }
            const float rstd = __builtin_amdgcn_rsqf(reduce8(sq) * (1.f / 64.f) + GN_EPS);
            float o[8];
#pragma unroll
            for (int i = 0; i < 8; ++i) { const float v = vc[i] + muv[i] * (vp[i] - vc[i]); const float yn = (y8[i] - mean) * rstd * gw[i] + gb[i] + cbon * v; o[i] = yn * z8[i] * sigmoidf_(z8[i]); }
            *(u32x4*)mrow = (u32x4){cvtpk(o[0], o[1]), cvtpk(o[2], o[3]), cvtpk(o[4], o[5]), cvtpk(o[6], o[7])};
        }
        BAR_LDS();
    }
#undef PB_LOAD
#undef PB_ELOAD
    __syncthreads();
}

#define XB_TMO      128
#define XB_XCNT(j)  (256  + 64 * (j))
#define XB_XSUB(j)  (1280 + 64 * (j))
#define XB_XGEN(j)  (2304 + 64 * (j))
#define XB_TOP      3328
#define XB_TOPGEN   3392
#define XCD_BAR_WORDS 3456
#define XB_SPIN_CAP (1u << 18)

__device__ __forceinline__ unsigned xb_ld(unsigned* p)              { return __hip_atomic_load(p, __ATOMIC_RELAXED, __HIP_MEMORY_SCOPE_AGENT); }
__device__ __forceinline__ unsigned xb_add(unsigned* p, unsigned v) { return __hip_atomic_fetch_add(p, v, __ATOMIC_RELAXED, __HIP_MEMORY_SCOPE_AGENT); }
__device__ __forceinline__ unsigned xb_xcc_id() { return (unsigned)__builtin_amdgcn_s_getreg((3 << 11) | 20) & 0xFu; }
#define XB_SPIN(cond, bar) do { unsigned _sp = 0; while (cond) { __builtin_amdgcn_s_sleep(1); \
    if ((++_sp & 255u) == 0u) { if (xb_ld(&(bar)[XB_TMO])) break; if (_sp > XB_SPIN_CAP) { atomicAdd(&(bar)[XB_TMO], 1u); break; } } } } while (0)

struct XcdBarrier {
    unsigned* bar; unsigned x;
    volatile LAS unsigned* st;
};

__device__ __forceinline__ XcdBarrier xcd_barrier_post(unsigned* bar, volatile LAS unsigned* st) {
    XcdBarrier b; b.bar = bar; b.x = xb_xcc_id(); b.st = st;
    if (threadIdx.x == 0) (void)xb_add(&bar[XB_XCNT(b.x)], 1u);
    return b;
}
__device__ __forceinline__ void xcd_barrier_complete(unsigned* bar, unsigned x, unsigned& nloc, unsigned& nx) {
    const unsigned G = gridDim.x * gridDim.y * gridDim.z;
    unsigned sum, cnt, mine, sp = 0u;
    for (;;) {
        sum = 0u; cnt = 0u; mine = 0u;
#pragma unroll
        for (unsigned j = 0; j < 16; ++j) { const unsigned c = xb_ld(&bar[XB_XCNT(j)]); sum += c; cnt += (c > 0u) ? 1u : 0u; mine = (j == x) ? c : mine; }
        if (sum == G) break;
        __builtin_amdgcn_s_sleep(1);
        if ((++sp & 255u) == 0u) { if (xb_ld(&bar[XB_TMO])) break; if (sp > XB_SPIN_CAP) { atomicAdd(&bar[XB_TMO], 1u); break; } }
    }
    nloc = mine > 0u ? mine : 1u; nx = cnt > 0u ? cnt : 1u;
}

__device__ __forceinline__ void xcd_barrier(const XcdBarrier& b) {
    asm volatile("s_waitcnt vmcnt(0)" ::: "memory");
    __syncthreads();
    if (threadIdx.x == 0) {
        unsigned* bar = b.bar;
        __builtin_amdgcn_s_waitcnt(0);
        unsigned nloc = b.st[0], nx = b.st[1];
        if (nloc == 0u) { xcd_barrier_complete(bar, b.x, nloc, nx); b.st[0] = nloc; b.st[1] = nx; }
        const unsigned old = xb_add(&bar[XB_XSUB(b.x)], 1u);
        const unsigned gen = old / nloc;
        if (old + 1u == (gen + 1u) * nloc) {
            __builtin_amdgcn_fence(__ATOMIC_RELEASE, "agent");
            asm volatile("s_waitcnt vmcnt(0)" ::: "memory");
            const unsigned og = xb_add(&bar[XB_TOP], 1u);
            const unsigned tg = og / nx;
            if (og + 1u == (tg + 1u) * nx) xb_add(&bar[XB_TOPGEN], 1u);
            else XB_SPIN(xb_ld(&bar[XB_TOPGEN]) == tg, bar);
            __builtin_amdgcn_fence(__ATOMIC_ACQUIRE, "agent");
            xb_add(&bar[XB_XGEN(b.x)], 1u);
            asm volatile("s_waitcnt vmcnt(0)" ::: "memory");
        } else {
            XB_SPIN(xb_ld(&bar[XB_XGEN(b.x)]) == gen, bar);
            __builtin_amdgcn_fence(__ATOMIC_ACQUIRE, "agent");
            asm volatile("s_waitcnt vmcnt(0)" ::: "memory");
        }
    }
    __syncthreads();
}

constexpr size_t WS_BAR = 13 * MiB + 768 * 1024;
constexpr int LDS_BARST = 146944;
__global__ void __launch_bounds__(NTHR, 2) hymba_fwd(Prm P) {
    extern __shared__ __attribute__((aligned(16))) unsigned char lds_raw[];
    LAS unsigned char* lds = (LAS unsigned char*)lds_raw;
    cg::grid_group grid = cg::this_grid();
    const int G = gridDim.x;
    if (threadIdx.x < 2) ((LAS unsigned*)(lds + LDS_BARST))[threadIdx.x] = 0u;
    __syncthreads();
    const XcdBarrier xbar = xcd_barrier_post((unsigned*)(P.ws + WS_BAR), (volatile LAS unsigned*)(lds + LDS_BARST));
    if (P.ws == nullptr) grid.sync();
    p0_prologue(P, lds, G);
    xcd_barrier(xbar);
    for (int j = G - 1 - (int)blockIdx.x; j < 64; j += G) cb_scan(P, j, lds);
    { pg8::Gemm g{(const pg8::bf16_t*)(P.ws + WS_U), (const pg8::bf16_t*)(P.ws + WS_WTIN), MP, NP, DM}; pg8::StaticOrder S; S.init(MP, NP, G, (int)blockIdx.x);
      pg8::EpiBf16 E{(pg8::bf16_t*)(P.ws + WS_P), NP};
      pg8::gemm_phase<pg8::EpiBf16, pg8::StaticOrder, true, true>(lds, g, S, E); }
    xcd_barrier(xbar);
    if (G == 256) { if ((blockIdx.x & 3) == 0) kmax_job(P, (int)(blockIdx.x >> 2), lds); }
    else for (int j = blockIdx.x; j < 64; j += G) kmax_job(P, j, lds);
    { const int NU = NB * 8 * NCHUNK; const int u0 = (int)(((long)blockIdx.x * NU) / G), u1 = (int)(((long)(blockIdx.x + 1) * NU) / G); int cur_head = -1;
      PAPre pf; if (u0 < u1) { const int t_ = opaque_tid(); pa_prefetch(P, u0, pf, t_, t_ & 63, __builtin_amdgcn_readfirstlane(t_ >> 6)); }
      for (int u = u0; u < u1; ++u) rwkv_pass_a(P, u, lds, cur_head, pf, u + 1 < u1 ? u + 1 : -1); }
    xcd_barrier(xbar);
    for (int bh = blockIdx.x; bh < 64; bh += G) rwkv_pass_b(P, bh, lds);
    { unsigned* ctr = (unsigned*)(P.ws + WS_CTR); LAS unsigned* uidx = (LAS unsigned*)(lds + AL_UIDX);
      const unsigned x0 = xb_xcc_id() & 7u;
      for (unsigned k = 0; k < 8u; ++k) {
          const unsigned x = (x0 + k) & 7u;
          for (;;) {
              if (threadIdx.x == 0) *uidx = atomicAdd(ctr + x * 64, 1u);
              __syncthreads();
              const unsigned u = *uidx;
              __syncthreads();
              if (u >= 128u) break;
              attn_unit(P, (int)(x * 8u + (u & 7u)), 15 - (int)(u >> 3), lds);
          }
      } }
    xcd_barrier(xbar);
    { pg8::Gemm g{(const pg8::bf16_t*)(P.ws + WS_MIX), (const pg8::bf16_t*)(P.ws + WS_WTOUT), MR, DM, DM}; pg8::StaticOrder S; S.init(MR, DM, G, (int)blockIdx.x);
      pg8::EpiResNorm E{P.x, P.out, (float*)(P.ws + WS_ROWSS), (unsigned*)(P.ws + WS_PCNT), P.fnw, DM};
      pg8::gemm_phase<pg8::EpiResNorm, pg8::StaticOrder, true, true>(lds, g, S, E); }
}

extern "C" void kernel_launch(void* const* d_in, const int* in_sizes, int n_in, void* d_out, int out_size, void* d_ws, size_t ws_size, hipStream_t stream) {
    static int grid_blocks = 0;
    if (!grid_blocks) {
        int dev = 0, cus = 0, per_cu = 0;
        (void)hipGetDevice(&dev);
        (void)hipDeviceGetAttribute(&cus, hipDeviceAttributeMultiprocessorCount, dev);
        (void)hipFuncSetAttribute((const void*)hymba_fwd, hipFuncAttributeMaxDynamicSharedMemorySize, LDS_BYTES);
        (void)hipOccupancyMaxActiveBlocksPerMultiprocessor(&per_cu, (const void*)hymba_fwd, NTHR, LDS_BYTES);
        if (per_cu < 1) { fprintf(stderr, "kernel_launch: occupancy query returned %d\n", per_cu); per_cu = 1; }
        grid_blocks = cus * 1;
        (void)hipGetLastError();
    }
    Prm p{};
    p.x = (const float*)d_in[0]; p.meta = (const float*)d_in[1]; p.norm_w = (const float*)d_in[2]; p.w_in = (const float*)d_in[3]; p.b_f = (const float*)d_in[4];
    p.mu = (const float*)d_in[5]; p.w0 = (const float*)d_in[6]; p.w_up = (const float*)d_in[7]; p.a0 = (const float*)d_in[8]; p.a_up = (const float*)d_in[9];
    p.k_k = (const float*)d_in[10]; p.k_a = (const float*)d_in[11]; p.r_k = (const float*)d_in[12]; p.gn_w = (const float*)d_in[13]; p.gn_b = (const float*)d_in[14];
    p.w_out = (const float*)d_in[15]; p.fnw = (const float*)d_in[16];
    p.out = (float*)d_out; p.ws = (unsigned char*)d_ws;
    (void)hipMemsetAsync((unsigned char*)d_ws + WS_BAR, 0, XCD_BAR_WORDS * 4, stream);
    void* args[] = {&p};
    hipError_t e = hipLaunchCooperativeKernel((const void*)hymba_fwd, dim3(grid_blocks), dim3(NTHR), args, LDS_BYTES, stream);
    if (e != hipSuccess) fprintf(stderr, "cooperative launch failed: %s (grid %d)\n", hipGetErrorString(e), grid_blocks);
}
```

```cpp
#include <hip/hip_runtime.h>
#include <hip/hip_cooperative_groups.h>
#include <cstdio>
#include <cstdint>
namespace cg = cooperative_groups;
namespace pg8 {
#define PG8_LAS __attribute__((address_space(3)))
typedef unsigned short bf16_t;
typedef short bf16x8 __attribute__((ext_vector_type(8)));
typedef float f32x4 __attribute__((ext_vector_type(4)));
typedef unsigned u32x4 __attribute__((ext_vector_type(4)));
constexpr int BM = 256, BK = 64, HALF = 128, HTB = HALF * BK * 2  , STAGE_BYTES = 8 * HTB, NXCD = 8, WGM = 8;

__host__ __device__ __forceinline__ int lds_byte(int r, int c) { const int st = (r >> 4) * 2 + (c >> 5), rr = r & 15, cc = c & 31, ob = rr * 64 + cc * 2; return st * 1024 + (ob ^ (((ob >> 9) & 1) << 5)); }
__host__ __device__ __forceinline__ void stage_rc(int b, int& R, int& C) { const int st = b / 1024, sb = b % 1024, swz = sb ^ (((sb >> 9) & 1) << 5); R = (st >> 1) * 16 + swz / 64; C = (st & 1) * 32 + (swz % 64) / 2; }
__host__ __device__ __forceinline__ int perm32(int rho) { const int n = rho >> 4, i = rho & 15; return 8 * (i >> 2) + 4 * n + (i & 3); }

struct Unit { int pm, pn; };
struct Gemm { const bf16_t* A; const bf16_t* Bt; int M, N, K; };

struct StaticOrder {
    int nM, nN, nwg, G, c;
    __host__ __device__ void init(int M, int N, int G_, int c_) { nM = M / BM; nN = N / BM; nwg = nM * nN; G = G_; c = c_; }
    __host__ __device__ bool next(int i, Unit& u) const {
        const long L = (long)i * G + c; if (L >= nwg) return false;
        int wgid = (int)L; { const int q = nwg / NXCD, r = nwg % NXCD, xcd = wgid % NXCD, off = wgid / NXCD; wgid = (xcd < r ? xcd * (q + 1) : r * (q + 1) + (xcd - r) * q) + off; }
        const int nig = WGM * nN, gid = wgid / nig, fm = gid * WGM, gsz = (nM - fm) < WGM ? (nM - fm) : WGM;
        u.pm = fm + ((wgid % nig) % gsz); u.pn = (wgid % nig) / gsz; return true;
    }
    __device__ __forceinline__ void a_ready(const Unit&) const {}
    __device__ __forceinline__ void done(const Unit&) const {}
};

__device__ __forceinline__ unsigned cvt_pk_bf16(float lo, float hi) { unsigned r; asm volatile("v_cvt_pk_bf16_f32 %0, %1, %2" : "=v"(r) : "v"(lo), "v"(hi)); return r; }
typedef float f32x2 __attribute__((ext_vector_type(2)));
struct EpiBf16 {
    static constexpr bool PERM = true, AFTER_DRAIN = false;
    bf16_t* O; int ldc;
    __device__ __forceinline__ void operator()(const f32x4 (&acc)[2][2][4][2], const Unit& u, int wr, int wc, int fr, int fq) const {
        const int row0 = u.pm * BM + wr * 64 + fr; const int col0 = u.pn * BM + wc * 32 + 8 * fq;
#pragma unroll
        for (int ai = 0; ai < 2; ++ai)
#pragma unroll
            for (int m = 0; m < 4; ++m) { bf16_t* rowp = O + (size_t)(row0 + ai * HALF + m * 16) * ldc + col0;
#pragma unroll
                for (int bj = 0; bj < 2; ++bj) { const f32x4 v0 = acc[ai][bj][m][0], v1 = acc[ai][bj][m][1];
                    u32x4 w; w.x = cvt_pk_bf16(v0[0], v0[1]); w.y = cvt_pk_bf16(v0[2], v0[3]); w.z = cvt_pk_bf16(v1[0], v1[1]); w.w = cvt_pk_bf16(v1[2], v1[3]);
                    *(u32x4*)(rowp + bj * HALF) = w; } }
    }
};
struct EpiRes {
    static constexpr bool PERM = false, AFTER_DRAIN = false;
    const float* base; float* out; float* rowss; int ldc;
    __device__ __forceinline__ void operator()(const f32x4 (&acc)[2][2][4][2], const Unit& u, int wr, int wc, int fr, int fq) const {
        const int col0 = u.pn * BM + wc * 32 + 4 * fq;
#pragma unroll
        for (int ai = 0; ai < 2; ++ai)
#pragma unroll
            for (int m = 0; m < 4; ++m) { const int row = u.pm * BM + ai * HALF + wr * 64 + m * 16 + fr; const size_t off = (size_t)row * ldc + col0; float ss = 0.f;
#pragma unroll
                for (int bj = 0; bj < 2; ++bj)
#pragma unroll
                    for (int n = 0; n < 2; ++n) { const f32x4 bs = *(const f32x4*)(base + off + bj * HALF + n * 16); const f32x4 o = bs + acc[ai][bj][m][n];
                        ss += (o[0] * o[0] + o[1] * o[1]) + (o[2] * o[2] + o[3] * o[3]); *(f32x4*)(out + off + bj * HALF + n * 16) = o; }
                ss += __shfl_xor(ss, 16); ss += __shfl_xor(ss, 32);
                if (fq == 0) atomicAdd(rowss + row, ss); }
    }
};
struct EpiResNorm {
    static constexpr bool PERM = false, AFTER_DRAIN = false;
    const float* base; float* out; float* rowss; unsigned* cnt; const float* fw; int ldc;
    __device__ __forceinline__ void operator()(f32x4 (&acc)[2][2][4][2], const Unit& u, int wr, int wc, int fr, int fq) const {
        const int col0 = u.pn * BM + wc * 32 + 4 * fq;
#pragma unroll
        for (int ai = 0; ai < 2; ++ai)
#pragma unroll
            for (int m = 0; m < 4; ++m) { const int row = u.pm * BM + ai * HALF + wr * 64 + m * 16 + fr; const size_t off = (size_t)row * ldc + col0; float ss = 0.f;
#pragma unroll
                for (int bj = 0; bj < 2; ++bj)
#pragma unroll
                    for (int n = 0; n < 2; ++n) { const f32x4 bs = *(const f32x4*)(base + off + bj * HALF + n * 16); const f32x4 o = bs + acc[ai][bj][m][n]; acc[ai][bj][m][n] = o;
                        ss += (o[0] * o[0] + o[1] * o[1]) + (o[2] * o[2] + o[3] * o[3]); }
                ss += __shfl_xor(ss, 16); ss += __shfl_xor(ss, 32);
                if (fq == 0) atomicAdd(rowss + row, ss); }
        asm volatile("s_waitcnt vmcnt(0)" ::: "memory");
        unsigned* pc = cnt + 64 * u.pm;
        if (fr == 0 && fq == 0) __hip_atomic_fetch_add(pc, 1u, __ATOMIC_RELAXED, __HIP_MEMORY_SCOPE_AGENT);
        { unsigned sp = 0; while (__hip_atomic_load(pc, __ATOMIC_RELAXED, __HIP_MEMORY_SCOPE_AGENT) < 32u) { __builtin_amdgcn_s_sleep(2); if (++sp > (1u << 22)) break; } }
        asm volatile("" ::: "memory");
        f32x4 fwv[2][2];
#pragma unroll
        for (int bj = 0; bj < 2; ++bj)
#pragma unroll
            for (int n = 0; n < 2; ++n) fwv[bj][n] = *(const f32x4*)(fw + col0 + bj * HALF + n * 16);
        float tots[2][4];
#pragma unroll
        for (int ai = 0; ai < 2; ++ai)
#pragma unroll
            for (int m = 0; m < 4; ++m) tots[ai][m] = __hip_atomic_load(rowss + u.pm * BM + ai * HALF + wr * 64 + m * 16 + fr, __ATOMIC_RELAXED, __HIP_MEMORY_SCOPE_AGENT);
#pragma unroll
        for (int ai = 0; ai < 2; ++ai)
#pragma unroll
            for (int m = 0; m < 4; ++m) { const int row = u.pm * BM + ai * HALF + wr * 64 + m * 16 + fr; const size_t off = (size_t)row * ldc + col0;
                const float tot = tots[ai][m]; const float rs = __builtin_amdgcn_rsqf(tot * (1.0f / 1024.0f) + 1e-6f);
#pragma unroll
                for (int bj = 0; bj < 2; ++bj)
#pragma unroll
                    for (int n = 0; n < 2; ++n) *(f32x4*)(out + off + bj * HALF + n * 16) = acc[ai][bj][m][n] * rs * fwv[bj][n]; }
    }
};
template <class Epi, class Sched, bool ALIGN_EPI = false, bool SP2 = false>
__device__ __forceinline__ void gemm_phase(PG8_LAS unsigned char* lds, const Gemm g, const Sched& S, const Epi& E) {
    const int tid = threadIdx.x, wid = __builtin_amdgcn_readfirstlane(tid >> 6), lane = tid & 63, wr = wid >> 2, wc = wid & 3, fr = lane & 15, fq = lane >> 4;
    const int K = g.K, nt = K / BK;
    unsigned voffA[2], voffB[2];
#pragma unroll
    for (int i = 0; i < 2; ++i) { int R, C; stage_rc(tid * 16 + i * 8192, R, C); const int Rb = Epi::PERM ? ((R & ~31) + perm32(R & 31)) : R;
        voffA[i] = (unsigned)(R * K + C) * 2u; voffB[i] = (unsigned)(Rb * K + C) * 2u; }
    const size_t kstep = (size_t)(BK * 2);
    const size_t hstep = (size_t)HALF * K * 2;
    const size_t tstep = 2 * hstep;
    const unsigned ldsw = (unsigned)wid * 1024u;
    const int aoff = lds_byte(wr * 64 + fr, fq * 8), boff = lds_byte(wc * 32 + fr, fq * 8);
#define PG8_SA(b, h) (((b) * 2 + (h)) * HTB)
#define PG8_SB(b, h) ((4 + (b) * 2 + (h)) * HTB)
#define PG8_STAGE(bufoff, gbase, voff) do { _Pragma("unroll") for (int _i = 0; _i < 2; ++_i) \
        __builtin_amdgcn_global_load_lds((const unsigned*)((const char*)(gbase) + (voff)[_i]), (PG8_LAS unsigned*)(lds + (bufoff) + ldsw + _i * 8192), 16, 0, 0); } while (0)
#define PG8_LDA(dst, b, h) do { _Pragma("unroll") for (int m = 0; m < 4; ++m) _Pragma("unroll") for (int k = 0; k < 2; ++k) dst[m][k] = *(const PG8_LAS bf16x8*)(lds + PG8_SA(b, h) + aoff + m * 2048 + k * 1024); } while (0)
#define PG8_LDB(dst, b, h) do { _Pragma("unroll") for (int n = 0; n < 2; ++n) _Pragma("unroll") for (int k = 0; k < 2; ++k) dst[n][k] = *(const PG8_LAS bf16x8*)(lds + PG8_SB(b, h) + boff + n * 2048 + k * 1024); } while (0)
#define PG8_MMA(ai, bj, At, Bt) do { __builtin_amdgcn_s_setprio(1); _Pragma("unroll") for (int m = 0; m < 4; ++m) _Pragma("unroll") for (int n = 0; n < 2; ++n) _Pragma("unroll") for (int k = 0; k < 2; ++k) \
        acc[ai][bj][m][n] = __builtin_amdgcn_mfma_f32_16x16x32_bf16(Bt[n][k], At[m][k], acc[ai][bj][m][n], 0, 0, 0); __builtin_amdgcn_s_setprio(0); } while (0)
#define PG8_WAIT_V(n) asm volatile("s_waitcnt vmcnt(" #n ")" ::: "memory")
#define PG8_WAIT_L(n) asm volatile("s_waitcnt lgkmcnt(" #n ")" ::: "memory")
#define PG8_BAR __builtin_amdgcn_s_barrier()
#define PG8_SCHED __builtin_amdgcn_sched_barrier(0)
    Unit cur, nxt; int ui = 0;
    if (!S.next(0, cur)) return;
    f32x4 acc[2][2][4][2];
#pragma unroll
    for (int a = 0; a < 2; ++a)
#pragma unroll
        for (int b = 0; b < 2; ++b)
#pragma unroll
            for (int m = 0; m < 4; ++m)
#pragma unroll
                for (int n = 0; n < 2; ++n) acc[a][b][m][n] = (f32x4){0.f, 0.f, 0.f, 0.f};
    bf16x8 At[4][2], B0[2][2], B1[2][2];
    const char* cA = (const char*)g.A + (size_t)cur.pm * tstep; const char* cB = (const char*)g.Bt + (size_t)cur.pn * tstep;
    S.a_ready(cur);
    if constexpr (SP2) {
        PG8_STAGE(PG8_SB(0, 0), cB, voffB); PG8_STAGE(PG8_SB(0, 1), cB + hstep, voffB); PG8_STAGE(PG8_SA(0, 0), cA, voffA); PG8_STAGE(PG8_SA(0, 1), cA + hstep, voffA);
        if (wr == 1) PG8_BAR;
        PG8_WAIT_V(2); PG8_BAR;
        PG8_STAGE(PG8_SB(1, 0), cB + kstep, voffB); PG8_STAGE(PG8_SA(1, 0), cA + kstep, voffA); PG8_STAGE(PG8_SB(1, 1), cB + hstep + kstep, voffB);
        PG8_WAIT_V(6); PG8_BAR;
    } else {
        PG8_STAGE(PG8_SB(0, 0), cB, voffB); PG8_STAGE(PG8_SA(0, 0), cA, voffA); PG8_STAGE(PG8_SB(0, 1), cB + hstep, voffB); PG8_STAGE(PG8_SA(0, 1), cA + hstep, voffA);
        if (wr == 1) PG8_BAR;
        PG8_WAIT_V(4); PG8_BAR;
        PG8_STAGE(PG8_SB(1, 0), cB + kstep, voffB); PG8_STAGE(PG8_SA(1, 0), cA + kstep, voffA); PG8_STAGE(PG8_SB(1, 1), cB + hstep + kstep, voffB);
        PG8_WAIT_V(6); PG8_BAR;
    }
    for (;;) {
        const bool has_next = S.next(ui + 1, nxt);
        const char* nA = has_next ? (const char*)g.A + (size_t)nxt.pm * tstep : cA; const char* nB = has_next ? (const char*)g.Bt + (size_t)nxt.pn * tstep : cB;
        for (int t = 0; t < nt; t += 2) {
            const bool last = (t == nt - 2);
            const char* a1 = cA + (size_t)(t + 1) * kstep;
            const char* a2 = last ? nA : cA + (size_t)(t + 2) * kstep; const char* b2 = last ? nB : cB + (size_t)(t + 2) * kstep;
            const char* a3 = a2 + kstep; const char* b3 = b2 + kstep;
            if (last && has_next) S.a_ready(nxt);
            if constexpr (SP2) {
            PG8_LDB(B0, 0, 0); PG8_LDB(B1, 0, 1); PG8_SCHED; PG8_LDA(At, 0, 0); PG8_STAGE(PG8_SA(1, 1), a1 + hstep, voffA);
            PG8_WAIT_V(8); PG8_WAIT_L(0); PG8_BAR; PG8_MMA(0, 0, At, B0); PG8_MMA(0, 1, At, B1); PG8_BAR; PG8_SCHED;
            PG8_LDA(At, 0, 1); PG8_STAGE(PG8_SB(0, 0), b2, voffB); PG8_STAGE(PG8_SB(0, 1), b2 + hstep, voffB); PG8_STAGE(PG8_SA(0, 0), a2, voffA);
            PG8_WAIT_V(8); PG8_WAIT_L(0); PG8_BAR; PG8_MMA(1, 0, At, B0); PG8_MMA(1, 1, At, B1); PG8_BAR; PG8_SCHED;
            PG8_LDB(B0, 1, 0); PG8_LDB(B1, 1, 1); PG8_SCHED; PG8_LDA(At, 1, 0); PG8_STAGE(PG8_SA(0, 1), a2 + hstep, voffA);
            PG8_WAIT_V(8); PG8_WAIT_L(0); PG8_BAR; PG8_MMA(0, 0, At, B0); PG8_MMA(0, 1, At, B1); PG8_BAR; PG8_SCHED;
            PG8_LDA(At, 1, 1); PG8_STAGE(PG8_SB(1, 0), b3, voffB); PG8_STAGE(PG8_SB(1, 1), b3 + hstep, voffB); PG8_STAGE(PG8_SA(1, 0), a3, voffA);
            PG8_WAIT_V(8); PG8_WAIT_L(0); PG8_BAR; PG8_MMA(1, 0, At, B0); PG8_MMA(1, 1, At, B1); PG8_BAR; PG8_SCHED;
            } else {
            PG8_LDB(B0, 0, 0); PG8_SCHED; PG8_LDA(At, 0, 0); PG8_STAGE(PG8_SA(1, 1), a1 + hstep, voffA);
            PG8_WAIT_L(8); PG8_BAR; PG8_WAIT_L(0); PG8_MMA(0, 0, At, B0); PG8_BAR; PG8_SCHED;
            PG8_LDB(B1, 0, 1); PG8_STAGE(PG8_SB(0, 0), b2, voffB);
            PG8_BAR; PG8_WAIT_L(0); PG8_MMA(0, 1, At, B1); PG8_BAR;
            PG8_LDA(At, 0, 1); PG8_STAGE(PG8_SA(0, 0), a2, voffA);
            PG8_BAR; PG8_WAIT_L(0); PG8_MMA(1, 0, At, B0); PG8_BAR; PG8_SCHED;
            PG8_STAGE(PG8_SB(0, 1), b2 + hstep, voffB);
            PG8_WAIT_V(6); PG8_BAR; PG8_MMA(1, 1, At, B1); PG8_BAR;
            PG8_LDB(B0, 1, 0); PG8_SCHED; PG8_LDA(At, 1, 0); PG8_STAGE(PG8_SA(0, 1), a2 + hstep, voffA);
            PG8_WAIT_L(8); PG8_BAR; PG8_WAIT_L(0); PG8_MMA(0, 0, At, B0); PG8_BAR; PG8_SCHED;
            PG8_LDB(B1, 1, 1); PG8_STAGE(PG8_SB(1, 0), b3, voffB);
            PG8_BAR; PG8_WAIT_L(0); PG8_MMA(0, 1, At, B1); PG8_BAR;
            PG8_LDA(At, 1, 1); PG8_STAGE(PG8_SA(1, 0), a3, voffA);
            PG8_BAR; PG8_WAIT_L(0); PG8_MMA(1, 0, At, B0); PG8_BAR; PG8_SCHED;
            PG8_STAGE(PG8_SB(1, 1), b3 + hstep, voffB);
            PG8_WAIT_V(6); PG8_BAR; PG8_MMA(1, 1, At, B1); PG8_BAR;
            }
        }
        if constexpr (ALIGN_EPI) { if (wr == 0) PG8_BAR; }
        if constexpr (!Epi::AFTER_DRAIN) { E(acc, cur, wr, wc, fr, fq); S.done(cur); }
        if (!has_next) break;
#pragma unroll
        for (int a = 0; a < 2; ++a)
#pragma unroll
            for (int b = 0; b < 2; ++b)
#pragma unroll
                for (int m = 0; m < 4; ++m)
#pragma unroll
                    for (int n = 0; n < 2; ++n) acc[a][b][m][n] = (f32x4){0.f, 0.f, 0.f, 0.f};
        cur = nxt; cA = nA; cB = nB; ++ui;
        if constexpr (ALIGN_EPI) { if (wr == 1) PG8_BAR; }
    }
    PG8_WAIT_V(0);
    if constexpr (!ALIGN_EPI) { if (wr == 0) PG8_BAR; }
    PG8_BAR;
    if constexpr (Epi::AFTER_DRAIN) { E.fused(acc, cur, wr, wc, fr, fq, lds, wid, lane); S.done(cur); }
#undef PG8_SA
#undef PG8_SB
#undef PG8_STAGE
#undef PG8_LDA
#undef PG8_LDB
#undef PG8_MMA
#undef PG8_WAIT_V
#undef PG8_WAIT_L
#undef PG8_BAR
#undef PG8_SCHED
}
}

#define LAS __attribute__((address_space(3)))
typedef unsigned short bf16;
typedef short bf16x8 __attribute__((ext_vector_type(8)));
typedef short s16x4 __attribute__((ext_vector_type(4)));
typedef float f32x4 __attribute__((ext_vector_type(4)));
typedef float f32x16 __attribute__((ext_vector_type(16)));
typedef unsigned u32x4 __attribute__((ext_vector_type(4)));
constexpr int NB = 8, SEQ = 4096, NMETA = 16, DM = 1024, PADR = 48;
constexpr int LP = PADR + NMETA + SEQ;
constexpr int MP = NB * LP;
constexpr int MR = NB * SEQ;
constexpr int NP = 4352;
constexpr int DIN = 4232;
constexpr int PC_Q = 0, PC_K = 512, PC_V = 1024, PC_ZF = 1536, PC_R = 2048, PC_RK = 2560, PC_RV = 3072, PC_WD = 3584, PC_AD = 3648, PC_ZR = 3712;
constexpr float LOG2E = 1.4426950408889634f;
constexpr float QSCALE = 0.125f * LOG2E;
constexpr size_t MiB = 1u << 20;
constexpr size_t WS_WTIN = 0, WS_WTOUT = 9 * MiB, WS_LF = 11 * MiB, WS_ROWSS = 13 * MiB, WS_CTR = 13 * MiB + 512 * 1024, WS_CB = 14 * MiB, WS_U = 16 * MiB, WS_P = 82 * MiB, WS_MIX = 360 * MiB;
constexpr size_t WS_KMAX = 13 * MiB + 512 * 1024 + 4096;
constexpr size_t WS_PCNT = 13 * MiB + 256 * 1024;
constexpr int LDS_BYTES = 163840;
constexpr int NTHR = 512;

struct Prm {
    const float *x, *meta, *norm_w, *w_in, *b_f, *mu, *w0, *w_up, *a0, *a_up, *k_k, *k_a, *r_k, *gn_w, *gn_b, *w_out, *fnw;
    float* out; unsigned char* ws;
};

__device__ __forceinline__ float wave_sum(float v) {
#pragma unroll
    for (int o = 1; o < 64; o <<= 1) v += __shfl_xor(v, o);
    return v;
}
__device__ __forceinline__ unsigned f2bf(float f) { unsigned u = __builtin_bit_cast(unsigned, f); return (u + 0x7fffu + ((u >> 16) & 1u)) >> 16; }
__device__ __forceinline__ unsigned pk2(float lo, float hi) { return f2bf(lo) | (f2bf(hi) << 16); }
__device__ __forceinline__ float bf_lo(unsigned w) { return __builtin_bit_cast(float, w << 16); }
__device__ __forceinline__ float bf_hi(unsigned w) { return __builtin_bit_cast(float, w & 0xffff0000u); }
__device__ __forceinline__ void unpack8(const u32x4 w, float* f) { f[0] = bf_lo(w.x); f[1] = bf_hi(w.x); f[2] = bf_lo(w.y); f[3] = bf_hi(w.y); f[4] = bf_lo(w.z); f[5] = bf_hi(w.z); f[6] = bf_lo(w.w); f[7] = bf_hi(w.w); }
template <int CTRL> __device__ __forceinline__ float dpp_mov(float v) { return __builtin_bit_cast(float, __builtin_amdgcn_update_dpp(0, __builtin_bit_cast(int, v), CTRL, 0xf, 0xf, true)); }
__device__ __forceinline__ float reduce8(float v) { v += dpp_mov<0xB1>(v); v += dpp_mov<0x4E>(v); v += dpp_mov<0x141>(v); return v; }
__device__ __forceinline__ float fexp(float x) { return __builtin_amdgcn_exp2f(x * 1.4426950408889634f); }
__device__ __forceinline__ float sigmoidf_(float x) { return __builtin_amdgcn_rcpf(1.f + fexp(-x)); }
__device__ __forceinline__ float ftanh(float x) { return 1.f - 2.f * __builtin_amdgcn_rcpf(1.f + fexp(2.f * x)); }
__device__ __forceinline__ float flog1pexp_neg(float ax) { return __builtin_amdgcn_logf(1.f + fexp(-ax)) * 0.6931471805599453f; }
typedef float f32x2_t __attribute__((ext_vector_type(2))); typedef __bf16 bf16x2_t __attribute__((ext_vector_type(2)));
__device__ __forceinline__ unsigned cvtpk(float lo, float hi) { f32x2_t v = {lo, hi}; bf16x2_t b = __builtin_convertvector(v, bf16x2_t); return __builtin_bit_cast(unsigned, b); }
#define LDSWAIT() asm volatile("s_waitcnt lgkmcnt(0)" ::: "memory")
#define BAR_LDS() asm volatile("s_waitcnt lgkmcnt(0)\n\ts_barrier" ::: "memory")
__device__ __forceinline__ float wave_sum_dpp(float v) {
    v += dpp_mov<0xB1>(v); v += dpp_mov<0x4E>(v); v += dpp_mov<0x141>(v); v += dpp_mov<0x140>(v);
    const int vi = __builtin_bit_cast(int, v);
    return (__builtin_bit_cast(float, __builtin_amdgcn_readlane(vi, 0)) + __builtin_bit_cast(float, __builtin_amdgcn_readlane(vi, 16))) +
           (__builtin_bit_cast(float, __builtin_amdgcn_readlane(vi, 32)) + __builtin_bit_cast(float, __builtin_amdgcn_readlane(vi, 48)));
}
__device__ __forceinline__ int opaque_tid() { int t = threadIdx.x; asm volatile("" : "+v"(t)); return t; }

__device__ __forceinline__ void transpose_item(const float* W, int ldw, int srccol0, bool zero, const float* kscale, float cs, bf16* WT, int n0, int k0, LAS float* scr, int lane) {
    float v[32], sc[32];
    if (zero) {
#pragma unroll
        for (int i = 0; i < 32; ++i) { v[i] = 0.f; sc[i] = 0.f; }
    } else {
        const float* wp = W + (size_t)(k0 + (lane >> 5)) * ldw + srccol0 + (lane & 31);
#pragma unroll
        for (int i = 0; i < 32; ++i) v[i] = wp[(size_t)(2 * i) * ldw];
        if (kscale) {
#pragma unroll
            for (int i = 0; i < 32; ++i) sc[i] = kscale[k0 + 2 * i + (lane >> 5)] * cs;
        } else {
#pragma unroll
            for (int i = 0; i < 32; ++i) sc[i] = cs;
        }
    }
#pragma unroll
    for (int i = 0; i < 32; ++i) scr[(2 * i + (lane >> 5)) * 33 + (lane & 31)] = v[i] * sc[i];
    LDSWAIT();
    const int c = lane & 7;
#pragma unroll
    for (int j = 0; j < 4; ++j) { const int n = (lane >> 3) + 8 * j; const LAS float* s = scr + (8 * c) * 33 + n;
        u32x4 o; o.x = pk2(s[0 * 33], s[1 * 33]); o.y = pk2(s[2 * 33], s[3 * 33]); o.z = pk2(s[4 * 33], s[5 * 33]); o.w = pk2(s[6 * 33], s[7 * 33]);
        *(u32x4*)(WT + (size_t)(n0 + n) * DM + k0 + 8 * c) = o; }
    LDSWAIT();
}

__device__ __forceinline__ const float* p0_rowsrc(const Prm& P, int m) { const int b = m / LP, pos = m % LP; if (pos < PADR) return nullptr;
    return pos < PADR + NMETA ? P.meta + (size_t)(pos - PADR) * DM : P.x + ((size_t)b * SEQ + (pos - PADR - NMETA)) * DM; }
__device__ __forceinline__ const float* p0_rowload(const Prm& P, int m, int lane, f32x4* v) {
    const float* src = m < MP ? p0_rowsrc(P, m) : nullptr;
    if (src) {
#pragma unroll
        for (int j = 0; j < 4; ++j) v[j] = *(const f32x4*)(src + 256 * j + 4 * lane); }
    return src;
}
__device__ __forceinline__ void p0_row(const Prm& P, int m, const float* src, const f32x4* v, const LAS float* wf, bf16* U, float* LF, int lane) {
    bf16* urow = U + (size_t)m * DM;
    if (!src) {
        u32x4 z = {0u, 0u, 0u, 0u};
        *(u32x4*)(urow + lane * 8) = z; *(u32x4*)(urow + 512 + lane * 8) = z;
        if (lane < 8) LF[(size_t)m * 8 + lane] = 0.f;
        return;
    }
    float ss = 0.f;
#pragma unroll
    for (int j = 0; j < 4; ++j) ss += (v[j][0] * v[j][0] + v[j][1] * v[j][1]) + (v[j][2] * v[j][2] + v[j][3] * v[j][3]);
    ss = wave_sum_dpp(ss);
    const float rs = __builtin_amdgcn_rsqf(ss * (1.f / DM) + 1e-6f);
    float acc[8];
#pragma unroll
    for (int h = 0; h < 8; ++h) acc[h] = 0.f;
#pragma unroll
    for (int j = 0; j < 4; ++j) {
#pragma unroll
        for (int e = 0; e < 4; ++e) { const int ix = ((4 * j + e) * 64 + lane) * 4; const f32x4 w0 = *(const LAS f32x4*)(wf + ix), w1 = *(const LAS f32x4*)(wf + 4096 + ix); const float xv = v[j][e];
            acc[0] += xv * w0[0]; acc[1] += xv * w0[1]; acc[2] += xv * w0[2]; acc[3] += xv * w0[3]; acc[4] += xv * w1[0]; acc[5] += xv * w1[1]; acc[6] += xv * w1[2]; acc[7] += xv * w1[3]; }
        unsigned long long o = (unsigned long long)cvtpk(v[j][0] * rs, v[j][1] * rs) | ((unsigned long long)cvtpk(v[j][2] * rs, v[j][3] * rs) << 32);
        *(unsigned long long*)(urow + 256 * j + 4 * lane) = o;
    }
    float mine = 0.f;
#pragma unroll
    for (int h = 0; h < 8; ++h) { const float s = wave_sum_dpp(acc[h]); if (lane == h) mine = s; }
    if (lane < 8) { const float xl = mine * rs + P.b_f[lane]; const float ls = fminf(xl, 0.f) - log1pf(__expf(-fabsf(xl))); LF[(size_t)m * 8 + lane] = ls * LOG2E; }
}
__device__ __forceinline__ void p0_prologue(const Prm& P, LAS unsigned char* lds, int G) {
    const int tid = opaque_tid(), lane = tid & 63, wid = tid >> 6;
    bf16* WTin = (bf16*)(P.ws + WS_WTIN); bf16* WTout = (bf16*)(P.ws + WS_WTOUT);
    float* LF = (float*)(P.ws + WS_LF); float* rowss = (float*)(P.ws + WS_ROWSS); unsigned* ctr = (unsigned*)(P.ws + WS_CTR);
    bf16* U = (bf16*)(P.ws + WS_U);
    LAS float* scr = (LAS float*)(lds + wid * 8448);
    LAS float* wf = (LAS float*)(lds + 69632);
    const int gw = blockIdx.x * 8 + wid, NGW = G * 8;
    if (blockIdx.x == 0 && tid < 8) ctr[tid * 64] = 0u;
    for (int i = blockIdx.x * NTHR + tid; i < MR; i += G * NTHR) rowss[i] = 0.f;
    if (blockIdx.x == 1) { unsigned* pc = (unsigned*)(P.ws + WS_PCNT); for (int i = tid; i < 128 * 64; i += NTHR) pc[i] = 0u; }
    for (int i = tid; i < 8192; i += NTHR) { const int k = i >> 3, h = i & 7; const int j = k >> 8, ln = (k & 255) >> 2, e = k & 3;
        wf[(h >> 2) * 4096 + ((4 * j + e) * 64 + ln) * 4 + (h & 3)] = P.norm_w[k] * P.w_in[(size_t)k * DIN + 1536 + h]; }
    constexpr int I_IN = 16 * (NP / 32), I_OUT = 16 * 32;
    for (int it = gw; it < I_IN + I_OUT; it += NGW) {
        if (it < I_IN) { const int kb = it / (NP / 32), nb = it % (NP / 32), n0 = nb * 32;
            transpose_item(P.w_in, DIN, n0 + (n0 >= 1536 ? 8 : 0), n0 >= 4224, P.norm_w, n0 < 512 ? QSCALE : 1.f, WTin, n0, kb * 64, scr, lane); }
        else { const int r = it - I_IN, kb = r / 32, nb = r % 32; transpose_item(P.w_out, DM, nb * 32, false, nullptr, 1.f, WTout, nb * 32, kb * 64, scr, lane); }
    }
    __syncthreads();
    f32x4 vA[4], vB[4]; const float* sA = p0_rowload(P, gw, lane, vA); const float* sB = p0_rowload(P, gw + NGW, lane, vB);
    for (int m = gw; m < MP; m += 2 * NGW) {
        p0_row(P, m, sA, vA, wf, U, LF, lane); sA = p0_rowload(P, m + 2 * NGW, lane, vA);
        if (m + NGW < MP) { p0_row(P, m + NGW, sB, vB, wf, U, LF, lane); sB = p0_rowload(P, m + 3 * NGW, lane, vB); }
    }
}

__device__ __forceinline__ void cb_scan(const Prm& P, int bh, LAS unsigned char* lds) {
    const int tid = opaque_tid(), lane = tid & 63, wid = tid >> 6, b = bh >> 3, h = bh & 7;
    const float* LF = (const float*)(P.ws + WS_LF); float* CB = (float*)(P.ws + WS_CB) + (size_t)bh * LP;
    LAS float* wt = (LAS float*)lds;
    float v[9]; float s = 0.f; const int k0 = tid * 9;
    float xv[9];
#pragma unroll
    for (int i = 0; i < 9; ++i) { const int k = k0 + i; xv[i] = LF[((size_t)b * LP + (k < LP ? k : LP - 1)) * 8 + h]; }
#pragma unroll
    for (int i = 0; i < 9; ++i) { const int k = k0 + i; const float x = k < LP ? xv[i] : 0.f; s += x; v[i] = s; }
    float inc = s;
#pragma unroll
    for (int o = 1; o < 64; o <<= 1) { const float t = __shfl_up(inc, o); if (lane >= o) inc += t; }
    if (lane == 63) wt[wid] = inc;
    __syncthreads();
    float base = inc - s;
    for (int w = 0; w < wid; ++w) base += wt[w];
#pragma unroll
    for (int i = 0; i < 9; ++i) { const int k = k0 + i; if (k < LP) CB[k] = k < PADR ? -1e30f : -(base + v[i]); }
    __syncthreads();
}

__device__ __forceinline__ int crow(int r, int hi) { return (r & 3) + 8 * (r >> 2) + 4 * hi; }
__device__ __forceinline__ unsigned cvtpk_s(float lo, float hi) { unsigned r; asm volatile("v_cvt_pk_bf16_f32 %0, %1, %2" : "=v"(r) : "v"(lo), "v"(hi)); return r; }
constexpr int KCH = 1056, KSUB = 8 * KCH;
__device__ __forceinline__ void qkt(f32x16& p0, f32x16& p1, const LAS unsigned char* Kslot, const bf16x8* qr, const f32x16& c0i, const f32x16& c1i, int r32, int hi) {
    const LAS unsigned char* kb = Kslot + hi * KCH + r32 * 16;
#pragma unroll
    for (int d0 = 0; d0 < 4; ++d0) {
        const bf16x8 b0 = *(const LAS bf16x8*)(kb + d0 * 2 * KCH);
        const bf16x8 b1 = *(const LAS bf16x8*)(kb + d0 * 2 * KCH + 512);
        if (d0 == 0) { p0 = __builtin_amdgcn_mfma_f32_32x32x16_bf16(b0, qr[0], c0i, 0, 0, 0); p1 = __builtin_amdgcn_mfma_f32_32x32x16_bf16(b1, qr[0], c1i, 0, 0, 0); }
        else { p0 = __builtin_amdgcn_mfma_f32_32x32x16_bf16(b0, qr[d0], p0, 0, 0, 0); p1 = __builtin_amdgcn_mfma_f32_32x32x16_bf16(b1, qr[d0], p1, 0, 0, 0); } }
}
typedef short v4i16_t __attribute__((ext_vector_type(4)));
__device__ __forceinline__ s16x4 vtr(const LAS unsigned char* p) { return __builtin_bit_cast(s16x4, __builtin_amdgcn_ds_read_tr16_b64_v4i16((LAS v4i16_t*)p)); }
__device__ __forceinline__ void pv(f32x16* o, const LAS unsigned char* vp, bf16x8 pa0, bf16x8 pa1, bf16x8 pa2, bf16x8 pa3) {
#pragma unroll
    for (int d0 = 0; d0 < 2; ++d0) { s16x4 lo[4], hi[4];
#pragma unroll
        for (int ks = 0; ks < 4; ++ks) { lo[ks] = vtr(vp + d0 * 4096 + ks * 1024); hi[ks] = vtr(vp + d0 * 4096 + ks * 1024 + 512); }
#define PK(k) (bf16x8){lo[k][0], lo[k][1], lo[k][2], lo[k][3], hi[k][0], hi[k][1], hi[k][2], hi[k][3]}
        o[d0] = __builtin_amdgcn_mfma_f32_32x32x16_bf16(pa0, PK(0), o[d0], 0, 0, 0);
        o[d0] = __builtin_amdgcn_mfma_f32_32x32x16_bf16(pa1, PK(1), o[d0], 0, 0, 0);
        o[d0] = __builtin_amdgcn_mfma_f32_32x32x16_bf16(pa2, PK(2), o[d0], 0, 0, 0);
        o[d0] = __builtin_amdgcn_mfma_f32_32x32x16_bf16(pa3, PK(3), o[d0], 0, 0, 0);
#undef PK
    }
}
constexpr int AL_K = 0, AL_V = 4 * KSUB, AL_CB = AL_V + 32768, AL_WSF = AL_CB + 16640, AL_UIDX = AL_WSF + 2048, AL_STOP = AL_UIDX + 64;
struct KVStage { u32x4 k0, k1, v0, v1; };

__device__ __forceinline__ void attn_sub(int t, int NT, const LAS unsigned char* Ks, const LAS unsigned char* vb, const LAS float* cbl, LAS float* wsf, const bf16x8* qr,
                                         int qpos, int r32, int hi, float& m_run, float& l_run, f32x16* o) {
        f32x16 p0, p1, c0i, c1i;
        const int kvb = t * 64 + 4 * hi;
#pragma unroll
        for (int g = 0; g < 4; ++g) { const f32x4 c0 = *(const LAS f32x4*)(cbl + kvb + 8 * g), c1 = *(const LAS f32x4*)(cbl + kvb + 32 + 8 * g);
#pragma unroll
            for (int e = 0; e < 4; ++e) { c0i[4 * g + e] = c0[e] - m_run; c1i[4 * g + e] = c1[e] - m_run; } }
        qkt(p0, p1, Ks, qr, c0i, c1i, r32, hi);
        if (t >= NT - 4) {
#pragma unroll
            for (int r = 0; r < 16; ++r) { const int kv = t * 64 + crow(r, hi); if (kv > qpos) p0[r] = -INFINITY; if (kv + 32 > qpos) p1[r] = -INFINITY; }
        }
        float rm = __builtin_fmaxf(p0[0], p1[0]);
#pragma unroll
        for (int r = 1; r < 16; ++r) rm = __builtin_fmaxf(__builtin_fmaxf(rm, p0[r]), p1[r]);
        { auto rr = __builtin_amdgcn_permlane32_swap(__float_as_uint(rm), __float_as_uint(rm), false, false); rm = fmaxf(__uint_as_float(rr[0]), __uint_as_float(rr[1])); }
        if (__any(rm > 32.f)) {
            const float dl = fmaxf(rm, 0.f); const float f = __builtin_amdgcn_exp2f(-dl); m_run += dl; l_run *= f;
#pragma unroll
            for (int r = 0; r < 16; ++r) { p0[r] -= dl; p1[r] -= dl; }
            if (hi == 0) wsf[r32] = f;
            LDSWAIT();
#pragma unroll
            for (int r = 0; r < 16; ++r) { const float fr_ = wsf[crow(r, hi)]; o[0][r] *= fr_; o[1][r] *= fr_; }
        }
        float sum = 0.f;
#pragma unroll
        for (int r = 0; r < 16; ++r) { p0[r] = __builtin_amdgcn_exp2f(p0[r]); p1[r] = __builtin_amdgcn_exp2f(p1[r]); sum += p0[r] + p1[r]; }
        l_run += sum;
        u32x4 pw0, pw1, pw2, pw3;
        pw0 = (u32x4){cvtpk(p0[0], p0[1]), cvtpk(p0[2], p0[3]), cvtpk(p0[4], p0[5]), cvtpk(p0[6], p0[7])};
        pw1 = (u32x4){cvtpk(p0[8], p0[9]), cvtpk(p0[10], p0[11]), cvtpk(p0[12], p0[13]), cvtpk(p0[14], p0[15])};
        pw2 = (u32x4){cvtpk(p1[0], p1[1]), cvtpk(p1[2], p1[3]), cvtpk(p1[4], p1[5]), cvtpk(p1[6], p1[7])};
        pw3 = (u32x4){cvtpk(p1[8], p1[9]), cvtpk(p1[10], p1[11]), cvtpk(p1[12], p1[13]), cvtpk(p1[14], p1[15])};
        pv(o, vb, __builtin_bit_cast(bf16x8, pw0), __builtin_bit_cast(bf16x8, pw1), __builtin_bit_cast(bf16x8, pw2), __builtin_bit_cast(bf16x8, pw3));
}
__device__ __forceinline__ void kv_load(KVStage& st, const bf16* ksrc, const bf16* vsrc, int t, int NT) {
    if (t < NT) { st.k0 = *(const u32x4*)(ksrc + (size_t)t * 64 * NP); st.v0 = *(const u32x4*)(vsrc + (size_t)t * 64 * NP); }
    if (t + 1 < NT) { st.k1 = *(const u32x4*)(ksrc + (size_t)(t + 1) * 64 * NP); st.v1 = *(const u32x4*)(vsrc + (size_t)(t + 1) * 64 * NP); }
}
__device__ __forceinline__ void kv_store(const KVStage& st, LAS unsigned char* lds, int kdst, int vdst, int slot, int t, int NT) {
    if (t < NT) { *(LAS u32x4*)(lds + kdst + slot * 2 * KSUB) = st.k0; *(LAS u32x4*)(lds + vdst + slot * 16384) = st.v0; }
    if (t + 1 < NT) { *(LAS u32x4*)(lds + kdst + slot * 2 * KSUB + KSUB) = st.k1; *(LAS u32x4*)(lds + vdst + slot * 16384 + 8192) = st.v1; }
}
__device__ __forceinline__ bool attn_period(int p, int NT, LAS unsigned char* lds, const bf16* ksrc, const bf16* vsrc, int kdst, int vdst, const LAS float* cbl, LAS float* wsf, const bf16x8* qr,
                                            int qpos, const LAS unsigned char* vb0, int r32, int hi, int wid, float qbound, float& m_run, float& l_run, f32x16* o, KVStage& sw, KVStage& sl) {
    const int cur = p & 1, t = 2 * p;
    if (p >= 2) kv_load(sl, ksrc, vsrc, t - 4, NT);
    const int qlast = (qpos | 31);
    if (t + 1 < NT && (t + 1) * 64 <= qlast) attn_sub(t + 1, NT, lds + AL_K + cur * 2 * KSUB + KSUB, vb0 + cur * 16384 + 8192, cbl, wsf, qr, qpos, r32, hi, m_run, l_run, o);
    if (t * 64 <= qlast) attn_sub(t, NT, lds + AL_K + cur * 2 * KSUB, vb0 + cur * 16384, cbl, wsf, qr, qpos, r32, hi, m_run, l_run, o);
    LAS unsigned* stopf = (LAS unsigned*)(lds + AL_STOP) + cur * 8;
    { const bool done = (p > 0) && __all(qbound + cbl[t * 64 - 1] - m_run < -160.f); if ((r32 | hi) == 0) stopf[wid] = done ? 1u : 0u; }
    if (p >= 2) asm volatile("s_waitcnt vmcnt(4)" ::: "memory"); else asm volatile("s_waitcnt vmcnt(0)" ::: "memory");
    if (p >= 1) kv_store(sw, lds, kdst, vdst, cur ^ 1, t - 2, NT);
    BAR_LDS();
    const u32x4 f0 = *(const LAS u32x4*)stopf, f1 = *(const LAS u32x4*)(stopf + 4);
    return (f0.x & f0.y & f0.z & f0.w & f1.x & f1.y & f1.z & f1.w) != 0u;
}

__device__ __forceinline__ void attn_unit(const Prm& P, int bh, int qb, LAS unsigned char* lds) {
    const int tid = opaque_tid(), lane = tid & 63, r32 = lane & 31, hi = lane >> 5; const int wid = __builtin_amdgcn_readfirstlane(tid >> 6);
    const int b = bh >> 3, h = bh & 7;
    const int q0 = 64 + 256 * qb, NT = (q0 + 256) / 64;
    const bf16* Pb = (const bf16*)(P.ws + WS_P) + (size_t)b * LP * NP;
    LAS float* cbl = (LAS float*)(lds + AL_CB); LAS float* wsf = (LAS float*)(lds + AL_WSF) + wid * 64;
    { const float* CB = (const float*)(P.ws + WS_CB) + (size_t)bh * LP; const int lim = q0 + 256; f32x4 cv[3];
#pragma unroll
      for (int i = 0; i < 3; ++i) { const int k = 4 * tid + 2048 * i; cv[i] = *(const f32x4*)(CB + (k < lim ? k : 0)); }
#pragma unroll
      for (int i = 0; i < 3; ++i) { const int k = 4 * tid + 2048 * i; if (k < lim) *(LAS f32x4*)(cbl + k) = cv[i]; } }
    const int krow = tid >> 3, kch = tid & 7;
    const bf16* ksrc = Pb + (size_t)krow * NP + PC_K + h * 64 + kch * 8; const int kdst = AL_K + kch * KCH + krow * 16;
    const int vrow = 16 * (wid & 3) + (lane >> 2), vd = 32 * (wid >> 2) + (lane & 3) * 8;
    const bf16* vsrc = Pb + (size_t)vrow * NP + PC_V + h * 64 + vd; const int vdst = AL_V + wid * 1024 + lane * 16;
    KVStage sA, sB;
    const int NPER = (NT + 1) / 2;
    kv_load(sB, ksrc, vsrc, 2 * (NPER - 1), NT); kv_load(sA, ksrc, vsrc, 2 * (NPER - 2), NT);
    const int qpos = q0 + wid * 32 + r32;
    const bf16* Qw = Pb + (size_t)qpos * NP + PC_Q + h * 64;
    bf16x8 qr[4];
#pragma unroll
    for (int d0 = 0; d0 < 4; ++d0) qr[d0] = *(const bf16x8*)(Qw + d0 * 16 + hi * 8);
    kv_store(sB, lds, kdst, vdst, (NPER - 1) & 1, 2 * (NPER - 1), NT);
    __syncthreads();
    const LAS unsigned char* vb0 = lds + AL_V + ((lane >> 4) & 1) * 32 + (lane & 3) * 8 + (4 * hi + ((lane & 15) >> 2)) * 64;
    float m_run = 0.f, l_run = 0.f; f32x16 o[2];
    o[0] = f32x16{}; o[1] = f32x16{};
    asm volatile("" : "+v"(qr[0]), "+v"(qr[1]), "+v"(qr[2]), "+v"(qr[3]));
    float qbound;
    { float sq = 0.f;
#pragma unroll
      for (int d0 = 0; d0 < 4; ++d0)
#pragma unroll
          for (int e = 0; e < 8; ++e) { const float v = __builtin_bit_cast(float, (unsigned)(unsigned short)qr[d0][e] << 16); sq += v * v; }
      auto rr = __builtin_amdgcn_permlane32_swap(__float_as_uint(sq), __float_as_uint(sq), false, false); sq = __uint_as_float(rr[0]) + __uint_as_float(rr[1]);
      qbound = sqrtf(sq) * ((const float*)(P.ws + WS_KMAX))[bh] * 1.02f + 1.f; }
    for (int p = NPER - 1; p >= 0; p -= 2) {
        if (attn_period(p, NT, lds, ksrc, vsrc, kdst, vdst, cbl, wsf, qr, qpos, vb0, r32, hi, wid, qbound, m_run, l_run, o, sA, sB)) break;
        if (p >= 1 && attn_period(p - 1, NT, lds, ksrc, vsrc, kdst, vdst, cbl, wsf, qr, qpos, vb0, r32, hi, wid, qbound, m_run, l_run, o, sB, sA)) break;
    }
    const float l_tot = l_run + __shfl_xor(l_run, 32);
    if (hi == 0) wsf[32 + r32] = l_tot;
    LDSWAIT();
    bf16* mix = (bf16*)(P.ws + WS_MIX);
    { LAS float* stg = (LAS float*)(lds + wid * 8192);
      const int erow = lane >> 1, eh = lane & 1; const int epos = q0 + wid * 32 + erow;
      const bf16* zr = Pb + (size_t)epos * NP + PC_ZF + h * 64 + eh * 32;
      u32x4 zw[4];
#pragma unroll
      for (int i = 0; i < 4; ++i) zw[i] = *(const u32x4*)(zr + 8 * i);
#pragma unroll
      for (int r = 0; r < 16; ++r) { const int q = crow(r, hi); const float rl = __builtin_amdgcn_rcpf(wsf[32 + q]);
#pragma unroll
          for (int d0 = 0; d0 < 2; ++d0) stg[q * 64 + d0 * 32 + r32] = o[d0][r] * rl; }
      LDSWAIT();
      bf16* mr = mix + ((size_t)b * SEQ + (epos - 64)) * DM + h * 64 + eh * 32;
#pragma unroll
      for (int i = 0; i < 4; ++i) { float zf[8], ov[8]; unpack8(zw[i], zf); { const f32x4 a = *(const LAS f32x4*)(stg + erow * 64 + eh * 32 + 8 * i), c = *(const LAS f32x4*)(stg + erow * 64 + eh * 32 + 8 * i + 4); ov[0] = a[0]; ov[1] = a[1]; ov[2] = a[2]; ov[3] = a[3]; ov[4] = c[0]; ov[5] = c[1]; ov[6] = c[2]; ov[7] = c[3]; }
#pragma unroll
          for (int e = 0; e < 8; ++e) ov[e] = ov[e] * zf[e] * sigmoidf_(zf[e]);
          *(u32x4*)(mr + 8 * i) = (u32x4){cvtpk(ov[0], ov[1]), cvtpk(ov[2], ov[3]), cvtpk(ov[4], ov[5]), cvtpk(ov[6], ov[7])}; } }
    __syncthreads();
}

__device__ __forceinline__ void kmax_job(const Prm& P, int bh, LAS unsigned char* lds) {
    const int tid = opaque_tid(), b = bh >> 3, h = bh & 7;
    const bf16* Kb = (const bf16*)(P.ws + WS_P) + (size_t)b * LP * NP + PC_K + h * 64 + (tid & 7) * 8;
    LAS unsigned* mx = (LAS unsigned*)lds;
    if (tid == 0) *mx = 0u;
    __syncthreads();
    float best = 0.f;
    for (int r0 = 0; r0 < LP; r0 += 64 * 13) {
        u32x4 w[13];
#pragma unroll
        for (int i = 0; i < 13; ++i) w[i] = *(const u32x4*)(Kb + (size_t)(r0 + 64 * i + (tid >> 3)) * NP);
#pragma unroll
        for (int i = 0; i < 13; ++i) { float f[8]; unpack8(w[i], f); float sq = 0.f;
#pragma unroll
            for (int e = 0; e < 8; ++e) sq += f[e] * f[e];
            best = fmaxf(best, reduce8(sq)); }
    }
    __hip_atomic_fetch_max(mx, __float_as_uint(best), __ATOMIC_RELAXED, __HIP_MEMORY_SCOPE_WORKGROUP);
    __syncthreads();
    if (tid == 0) ((float*)(P.ws + WS_KMAX))[bh] = sqrtf(__uint_as_float(*mx));
    __syncthreads();
}

constexpr float GN_EPS = 64e-5f;
constexpr int NCHUNK = LP / 64;
constexpr int MS = 72;
constexpr int MB = 64 * MS * 2;
constexpr int PA_ACTW = 0, PA_ACTA = 8192;
constexpr int PA_AAB = 0, PA_AAK = MB, PA_ARB = 2 * MB, PA_ARK = 3 * MB;
constexpr int PA_L = 36864;
constexpr int PA_AABF = PA_L, PA_T = PA_L + 16384, PA_T11T = PA_L + 16384 + MB;
constexpr int PA_SEG = 69632, PA_TOT = PA_SEG + 2048, PA_OP = 72192;
constexpr int PA_AT = PA_OP, PA_BT = PA_OP + MB, PA_KT = PA_OP + 2 * MB, PA_RT = PA_OP + 3 * MB, PA_ATT = PA_OP + 4 * MB, PA_BHT = PA_OP + 5 * MB, PA_KHT = PA_OP + 6 * MB, PA_VT = PA_OP + 7 * MB;
constexpr int PA_AVT = PA_AT, PA_UAT = PA_BT, PA_UVT = PA_KT, PA_M2T = PA_KT;
constexpr int PA_WUPT = 147456, PA_AUPT = 155648;
static_assert(PA_OP + 8 * MB <= 146432 && PA_AUPT + 8192 <= LDS_BYTES, "pass A LDS map");
constexpr size_t WS_G = 16 * MiB, WS_Q = 16 * MiB + (size_t)NB * 8 * NCHUNK * 8192, WS_BON = 358 * MiB + 512 * 1024, WS_HV = 424 * MiB;
static_assert(WS_Q + (size_t)NB * 8 * NCHUNK * 8192 <= 82 * MiB && WS_HV + (size_t)NB * 8 * NCHUNK * 16384 <= 512 * MiB, "ws map");

__device__ __forceinline__ void load8(const float* p, float* f) { const f32x4 a = *(const f32x4*)p, b = *(const f32x4*)(p + 4); f[0] = a[0]; f[1] = a[1]; f[2] = a[2]; f[3] = a[3]; f[4] = b[0]; f[5] = b[1]; f[6] = b[2]; f[7] = b[3]; }
__device__ __forceinline__ void lload8(const LAS float* p, float* f) { const f32x4 a = *(const LAS f32x4*)p, b = *(const LAS f32x4*)(p + 4); f[0] = a[0]; f[1] = a[1]; f[2] = a[2]; f[3] = a[3]; f[4] = b[0]; f[5] = b[1]; f[6] = b[2]; f[7] = b[3]; }
__device__ __forceinline__ void shift8(const bf16* cur, const bf16* prev, bool has_prev, const float* mu, float* out) {
    float c[8], p[8], m[8];
    const u32x4 cw = *(const u32x4*)cur; u32x4 pw = *(const u32x4*)(has_prev ? prev : cur);
    load8(mu, m);
    if (!has_prev) pw = (u32x4){0u, 0u, 0u, 0u};
    unpack8(cw, c); unpack8(pw, p);
#pragma unroll
    for (int i = 0; i < 8; ++i) out[i] = c[i] + m[i] * (p[i] - c[i]);
}
__device__ __forceinline__ float ldbf(const bf16* p) { return __builtin_bit_cast(float, (unsigned)(*p) << 16); }
template <int KS> __device__ __forceinline__ f32x16 mm_tile(const LAS unsigned char* a, const LAS unsigned char* b, f32x16 acc, int r32, int hi) {
#pragma unroll
    for (int ks = 0; ks < KS; ++ks) { const bf16x8 af = *(const LAS bf16x8*)(a + (r32 * MS + hi * 8 + ks * 16) * 2), bfr = *(const LAS bf16x8*)(b + (r32 * MS + hi * 8 + ks * 16) * 2);
        acc = __builtin_amdgcn_mfma_f32_32x32x16_bf16(af, bfr, acc, 0, 0, 0); }
    return acc;
}
__device__ __forceinline__ void st_rm(LAS unsigned char* d, const f32x16& acc, int r32, int hi) {
#pragma unroll
    for (int r = 0; r < 16; r += 2) { const unsigned w = cvtpk(acc[r], acc[r + 1]); *(LAS bf16*)(d + (crow(r, hi) * MS + r32) * 2) = (bf16)(w & 0xffffu); *(LAS bf16*)(d + (crow(r + 1, hi) * MS + r32) * 2) = (bf16)(w >> 16); }
}
__device__ __forceinline__ void st_tr(LAS unsigned char* d, const f32x16& acc, int r32, int hi) {
#pragma unroll
    for (int g = 0; g < 4; ++g) { const unsigned long long w = (unsigned long long)cvtpk(acc[4 * g], acc[4 * g + 1]) | ((unsigned long long)cvtpk(acc[4 * g + 2], acc[4 * g + 3]) << 32);
        *(LAS unsigned long long*)(d + (r32 * MS + 8 * g + 4 * hi) * 2) = w; }
}

struct PAPre { u32x4 cwd, cad, pwd, pad; unsigned gr[9], gk[9], gv[9]; };
__device__ __forceinline__ void pa_prefetch(const Prm& P, int unit, PAPre& pf, int tid, int lane, int wid) {
    const int bh = unit / NCHUNK, ck = unit % NCHUNK, b = bh >> 3, h = bh & 7;
    const bf16* Pb = (const bf16*)(P.ws + WS_P) + (size_t)b * LP * NP;
    { const int tt = tid >> 3, cg = tid & 7; const int t = ck * 64 + tt; const bf16* prow = Pb + (size_t)t * NP; const bf16* qrow = t > 0 ? prow - NP : prow;
      pf.cwd = *(const u32x4*)(prow + PC_WD + cg * 8); pf.cad = *(const u32x4*)(prow + PC_AD + cg * 8);
      pf.pwd = *(const u32x4*)(qrow + PC_WD + cg * 8); pf.pad = *(const u32x4*)(qrow + PC_AD + cg * 8); }
    { const int hc_ = h * 64 + lane, t0_ = ck * 64 + 8 * wid;
#pragma unroll
      for (int i = 0; i < 9; ++i) { const int t_ = t0_ - 1 + i; const bf16* q = Pb + (size_t)(t_ < 0 ? 0 : t_) * NP + hc_; pf.gr[i] = q[PC_R]; pf.gk[i] = q[PC_RK]; pf.gv[i] = q[PC_RV]; } }
}

__device__ __forceinline__ void rwkv_pass_a(const Prm& P, int unit, LAS unsigned char* lds, int& cur_head, PAPre& pf, int next_unit) {
    const int tid = opaque_tid(), lane = tid & 63, r32 = lane & 31, hi = lane >> 5; const int wid = __builtin_amdgcn_readfirstlane(tid >> 6);
    const int bh = unit / NCHUNK, ck = unit % NCHUNK, b = bh >> 3, h = bh & 7;
    const bf16* Pb = (const bf16*)(P.ws + WS_P) + (size_t)b * LP * NP;
    unsigned gr[9], gk[9], gv[9];
#pragma unroll
    for (int i = 0; i < 9; ++i) { gr[i] = pf.gr[i]; gk[i] = pf.gk[i]; gv[i] = pf.gv[i]; }
    if (ck * 64 + 8 * wid == 0) { gr[0] = 0u; gk[0] = 0u; gv[0] = 0u; }
    if (h != cur_head) { cur_head = h; const int c = tid & 63, jg = tid >> 6; float w[8], a[8];
#pragma unroll
        for (int i = 0; i < 8; ++i) { w[i] = P.w_up[(size_t)(jg * 8 + i) * 512 + h * 64 + c]; a[i] = P.a_up[(size_t)(jg * 8 + i) * 512 + h * 64 + c]; }
        *(LAS u32x4*)(lds + PA_WUPT + (c * 64 + jg * 8) * 2) = (u32x4){pk2(w[0], w[1]), pk2(w[2], w[3]), pk2(w[4], w[5]), pk2(w[6], w[7])};
        *(LAS u32x4*)(lds + PA_AUPT + (c * 64 + jg * 8) * 2) = (u32x4){pk2(a[0], a[1]), pk2(a[2], a[3]), pk2(a[4], a[5]), pk2(a[6], a[7])}; }
    { const int tt = tid >> 3, cg = tid & 7; const int t = ck * 64 + tt; const bool hp = t > 0;
      float xs[8], ys[8];
      const u32x4 cwd = pf.cwd, cad = pf.cad; u32x4 pwd = pf.pwd, pad = pf.pad;
      float mw[8], ma[8]; load8(P.mu + 1536 + cg * 8, mw); load8(P.mu + 1600 + cg * 8, ma);
      if (!hp) { pwd = (u32x4){0u, 0u, 0u, 0u}; pad = pwd; }
      { float c[8], p[8]; unpack8(cwd, c); unpack8(pwd, p);
#pragma unroll
        for (int i = 0; i < 8; ++i) xs[i] = ftanh(c[i] + mw[i] * (p[i] - c[i]));
        unpack8(cad, c); unpack8(pad, p);
#pragma unroll
        for (int i = 0; i < 8; ++i) ys[i] = c[i] + ma[i] * (p[i] - c[i]); }
      *(LAS u32x4*)(lds + PA_ACTW + (tt * 64 + cg * 8) * 2) = (u32x4){cvtpk(xs[0], xs[1]), cvtpk(xs[2], xs[3]), cvtpk(xs[4], xs[5]), cvtpk(xs[6], xs[7])};
      *(LAS u32x4*)(lds + PA_ACTA + (tt * 64 + cg * 8) * 2) = (u32x4){cvtpk(ys[0], ys[1]), cvtpk(ys[2], ys[3]), cvtpk(ys[4], ys[5]), cvtpk(ys[6], ys[7])}; }
    __syncthreads();
    { const int sel = wid >> 2, tm = (wid >> 1) & 1, tn = wid & 1;
      const LAS unsigned char* act = lds + (sel ? PA_ACTA : PA_ACTW) + ((32 * tm + r32) * 64 + hi * 8) * 2;
      const LAS unsigned char* wt = lds + (sel ? PA_AUPT : PA_WUPT) + ((32 * tn + r32) * 64 + hi * 8) * 2;
      f32x16 acc = {};
#pragma unroll
      for (int ks = 0; ks < 4; ++ks) { const bf16x8 af = *(const LAS bf16x8*)(act + ks * 32), bfr = *(const LAS bf16x8*)(wt + ks * 32); acc = __builtin_amdgcn_mfma_f32_32x32x16_bf16(af, bfr, acc, 0, 0, 0); }
      LAS float* lo = (LAS float*)(lds + PA_L + sel * 16384);
#pragma unroll
      for (int r = 0; r < 16; ++r) lo[(32 * tm + crow(r, hi)) * 64 + 32 * tn + r32] = acc[r]; }
    __syncthreads();
    {
        const int c = lane, hc = h * 64 + c, t0 = ck * 64 + 8 * wid;
        const float mu_r = P.mu[hc], mu_k = P.mu[512 + hc], mu_v = P.mu[1024 + hc], w0c = P.w0[hc], a0c = P.a0[hc], kkc = P.k_k[hc], kac = P.k_a[hc], rkc = P.r_k[hc];
        float pr = __builtin_bit_cast(float, (unsigned)gr[0] << 16), pk = __builtin_bit_cast(float, (unsigned)gk[0] << 16), pv_ = __builtin_bit_cast(float, (unsigned)gv[0] << 16);
        float lw[8], cum[8], rr[8], k2[8], vv[8], av[8], bv[8];
        float run = 0.f;
        float* bong = (float*)(P.ws + WS_BON) + (size_t)unit * 64;
#pragma unroll
        for (int i = 0; i < 8; ++i) {
            const float cr = __builtin_bit_cast(float, (unsigned)gr[i + 1] << 16), ckk = __builtin_bit_cast(float, (unsigned)gk[i + 1] << 16), cv = __builtin_bit_cast(float, (unsigned)gv[i + 1] << 16);
            rr[i] = cr + mu_r * (pr - cr); const float kx = ckk + mu_k * (pk - ckk); vv[i] = cv + mu_v * (pv_ - cv); pr = cr; pk = ckk; pv_ = cv;
            const float xw = ((const LAS float*)(lds + PA_L))[(8 * wid + i) * 64 + c] + w0c, xa = ((const LAS float*)(lds + PA_L + 16384))[(8 * wid + i) * 64 + c] + a0c;
            const float nx = -xw; const float sp = fmaxf(nx, 0.f) + flog1pexp_neg(fabsf(nx));
            lw[i] = -fexp(-sp - 0.5f); run += lw[i]; cum[i] = run;
            const float alpha = sigmoidf_(xa);
            float kn = kx * kkc; const float ss = wave_sum_dpp(kn * kn); kn *= __builtin_amdgcn_rsqf(ss + 1e-12f);
            k2[i] = kx * (1.f + (alpha - 1.f) * kac); av[i] = -kn; bv[i] = kn * alpha;
            const float bon = wave_sum_dpp(rr[i] * k2[i] * rkc);
            if (lane == 0) bong[8 * wid + i] = bon;
        }
        ((LAS float*)(lds + PA_SEG))[wid * 64 + c] = run;
        __syncthreads();
        float pre = 0.f, tot = 0.f;
#pragma unroll
        for (int g = 0; g < 8; ++g) { const float sgv = ((const LAS float*)(lds + PA_SEG))[g * 64 + c]; tot += sgv; if (g < wid) pre += sgv; }
        if (wid == 0) ((LAS float*)(lds + PA_TOT))[c] = tot;
        unsigned att[4], bht[4], kht[4], vt[4]; float tA[8], tB[8], tK[8];
#pragma unroll
        for (int i = 0; i < 8; ++i) {
            const float cm = pre + cum[i]; const float e2 = fexp(cm), e1 = fexp(cm - lw[i]), e3 = fexp(-cm), e4 = fexp(tot - cm);
            const int row = 8 * wid + i;
            tA[i] = av[i] * e1; tB[i] = bv[i] * e4; tK[i] = k2[i] * e4;
            const unsigned w0_ = cvtpk(tA[i], rr[i] * e2), w1_ = cvtpk(bv[i] * e3, k2[i] * e3);
            *(LAS bf16*)(lds + PA_AT + (row * MS + c) * 2) = (bf16)(w0_ & 0xffffu);
            *(LAS bf16*)(lds + PA_RT + (row * MS + c) * 2) = (bf16)(w0_ >> 16);
            *(LAS bf16*)(lds + PA_BT + (row * MS + c) * 2) = (bf16)(w1_ & 0xffffu);
            *(LAS bf16*)(lds + PA_KT + (row * MS + c) * 2) = (bf16)(w1_ >> 16);
        }
#pragma unroll
        for (int i = 0; i < 4; ++i) { att[i] = cvtpk(tA[2 * i], tA[2 * i + 1]); bht[i] = cvtpk(tB[2 * i], tB[2 * i + 1]); kht[i] = cvtpk(tK[2 * i], tK[2 * i + 1]); vt[i] = cvtpk(vv[2 * i], vv[2 * i + 1]); }
        *(LAS u32x4*)(lds + PA_ATT + (c * MS + 8 * wid) * 2) = (u32x4){att[0], att[1], att[2], att[3]};
        *(LAS u32x4*)(lds + PA_BHT + (c * MS + 8 * wid) * 2) = (u32x4){bht[0], bht[1], bht[2], bht[3]};
        *(LAS u32x4*)(lds + PA_KHT + (c * MS + 8 * wid) * 2) = (u32x4){kht[0], kht[1], kht[2], kht[3]};
        *(LAS u32x4*)(lds + PA_VT + (c * MS + 8 * wid) * 2) = (u32x4){vt[0], vt[1], vt[2], vt[3]};
    }
    __syncthreads();
    if (next_unit >= 0) pa_prefetch(P, next_unit, pf, tid, lane, wid);
    {
        const int mat = wid >> 1;
        const LAS unsigned char* Am = lds + ((mat & 2) ? PA_RT : PA_AT); const LAS unsigned char* Bm = lds + ((mat & 1) ? PA_KT : PA_BT);
        LAS unsigned char* D = lds + PA_AAB + mat * MB; const bool strict = mat < 2;
        if ((wid & 1) == 0) {
#pragma unroll
            for (int d = 0; d < 2; ++d) {
                f32x16 acc = {}; acc = mm_tile<4>(Am + d * 32 * MS * 2, Bm + d * 32 * MS * 2, acc, r32, hi);
#pragma unroll
                for (int r = 0; r < 16; ++r) { const int tl = crow(r, hi); const bool keep = strict ? (r32 < tl) : (r32 <= tl); acc[r] = keep ? acc[r] : 0.f; }
                st_rm(D + (d * 32 * MS + d * 32) * 2, acc, r32, hi);
                if (mat == 0) {
#pragma unroll
                    for (int r = 0; r < 16; ++r) ((LAS float*)(lds + PA_AABF))[(d * 32 + crow(r, hi)) * 64 + d * 32 + r32] = acc[r]; }
            }
        } else {
            f32x16 acc = {}; acc = mm_tile<4>(Am + 32 * MS * 2, Bm, acc, r32, hi);
            st_rm(D + (32 * MS) * 2, acc, r32, hi);
            f32x16 z = {}; st_rm(D + 32 * 2, z, r32, hi);
        }
    }
    __syncthreads();
    f32x16 yl = {}, hv = {};
    const int tm4 = (wid >> 1) & 1, tn4 = wid & 1;
    if (wid == 0) {
        const int blk = hi, c = r32; float T[32]; int offs[34];
        const LAS float* Ab = (const LAS float*)(lds + PA_AABF) + (blk * 32) * 64 + blk * 32;
        offs[0] = 0; offs[1] = 64;
#pragma unroll
        for (int t = 0; t < 32; ++t) {
            float ac4[4] = {(t == c) ? 1.f : 0.f, 0.f, 0.f, 0.f};
            const LAS float* Ar = Ab + offs[t];
#pragma unroll
            for (int s4 = 0; s4 < (t + 3) / 4; ++s4) { const f32x4 a4 = *(const LAS f32x4*)(Ar + 4 * s4);
#pragma unroll
                for (int e = 0; e < 4; ++e) if (4 * s4 + e < t) ac4[e] += a4[e] * T[4 * s4 + e]; }
            T[t] = (ac4[0] + ac4[1]) + (ac4[2] + ac4[3]);
            int ro = (t + 2) * 64; asm volatile("" : "+v"(ro), "+v"(T[t]));
            offs[t + 2] = ro;
        }
        LAS unsigned char* Td = lds + PA_T;
#pragma unroll
        for (int t = 0; t < 32; ++t) { *(LAS bf16*)(Td + ((blk * 32 + t) * MS + blk * 32 + c) * 2) = (bf16)f2bf(T[t]); if (blk == 0) *(LAS bf16*)(Td + (t * MS + 32 + c) * 2) = 0; }
        if (blk == 0) {
#pragma unroll
            for (int g = 0; g < 4; ++g) *(LAS u32x4*)(lds + PA_T11T + (c * MS + 8 * g) * 2) = (u32x4){pk2(T[8 * g], T[8 * g + 1]), pk2(T[8 * g + 2], T[8 * g + 3]), pk2(T[8 * g + 4], T[8 * g + 5]), pk2(T[8 * g + 6], T[8 * g + 7])}; }
    } else if (wid >= 4) {
        const LAS unsigned char* Vb = lds + PA_VT + tn4 * 32 * MS * 2;
        f32x16 av_ = {}; av_ = mm_tile<4>(lds + PA_AAK + tm4 * 32 * MS * 2, Vb, av_, r32, hi);
        yl = mm_tile<4>(lds + PA_ARK + tm4 * 32 * MS * 2, Vb, yl, r32, hi);
        hv = mm_tile<4>(lds + PA_KHT + tm4 * 32 * MS * 2, Vb, hv, r32, hi);
        st_tr(lds + PA_AVT + (tn4 * 32 * MS + tm4 * 32) * 2, av_, r32, hi);
    }
    __syncthreads();
    if (wid == 0) { f32x16 acc = {}; acc = mm_tile<2>(lds + PA_AAB + 32 * MS * 2, lds + PA_T11T, acc, r32, hi); st_tr(lds + PA_M2T, acc, r32, hi); }
    __syncthreads();
    if (wid == 0) { f32x16 acc = {}; acc = mm_tile<2>(lds + PA_T + (32 * MS + 32) * 2, lds + PA_M2T, acc, r32, hi); st_rm(lds + PA_T + (32 * MS) * 2, acc, r32, hi); }
    __syncthreads();
    { f32x16 acc = {}; const LAS unsigned char* Bsrc = lds + (wid < 4 ? PA_ATT : PA_AVT) + tn4 * 32 * MS * 2;
      acc = mm_tile<4>(lds + PA_T + tm4 * 32 * MS * 2, Bsrc, acc, r32, hi);
      __syncthreads();
      st_tr(lds + (wid < 4 ? PA_UAT : PA_UVT) + (tn4 * 32 * MS + tm4 * 32) * 2, acc, r32, hi); }
    __syncthreads();
    if (wid < 4) {
        const LAS unsigned char* Ub = lds + PA_UAT + tn4 * 32 * MS * 2;
        f32x16 q = {}; q = mm_tile<4>(lds + PA_ARB + tm4 * 32 * MS * 2, Ub, q, r32, hi);
        f32x16 g = {}; g = mm_tile<4>(lds + PA_BHT + tm4 * 32 * MS * 2, Ub, g, r32, hi);
        bf16* Qg = (bf16*)(P.ws + WS_Q) + (size_t)unit * 4096; bf16* Gg = (bf16*)(P.ws + WS_G) + (size_t)unit * 4096;
        const float pc = __expf(((const LAS float*)(lds + PA_TOT))[tn4 * 32 + r32]);
#pragma unroll
        for (int r = 0; r < 16; ++r) { const int row = tm4 * 32 + crow(r, hi), col = tn4 * 32 + r32;
            const float rt = __builtin_bit_cast(float, (unsigned)(*(const LAS bf16*)(lds + PA_RT + (row * MS + col) * 2)) << 16);
            const unsigned w = cvtpk(q[r] + rt, g[r] + (row == col ? pc : 0.f)); Qg[row * 64 + col] = (bf16)(w & 0xffffu); Gg[row * 64 + col] = (bf16)(w >> 16); }
    } else {
        const LAS unsigned char* Ub = lds + PA_UVT + tn4 * 32 * MS * 2;
        yl = mm_tile<4>(lds + PA_ARB + tm4 * 32 * MS * 2, Ub, yl, r32, hi);
        hv = mm_tile<4>(lds + PA_BHT + tm4 * 32 * MS * 2, Ub, hv, r32, hi);
        float* HVg = (float*)(P.ws + WS_HV) + (size_t)unit * 4096 + ((wid & 3) * 64 + lane) * 16;
#pragma unroll
        for (int g = 0; g < 4; ++g) *(f32x4*)(HVg + 4 * g) = (f32x4){hv[4 * g], hv[4 * g + 1], hv[4 * g + 2], hv[4 * g + 3]};
        if (ck >= 1) { bf16* mix = (bf16*)(P.ws + WS_MIX) + ((size_t)b * SEQ + (ck * 64 - 64)) * DM + 512 + h * 64;
#pragma unroll
            for (int r = 0; r < 16; r += 2) { const unsigned w = cvtpk(yl[r], yl[r + 1]); mix[(size_t)(tm4 * 32 + crow(r, hi)) * DM + tn4 * 32 + r32] = (bf16)(w & 0xffffu); mix[(size_t)(tm4 * 32 + crow(r + 1, hi)) * DM + tn4 * 32 + r32] = (bf16)(w >> 16); } }
    }
    __syncthreads();
}

constexpr int PB_S0 = 0, PB_S1 = MB, PB_Y = 2 * MB;
__device__ __forceinline__ void rwkv_pass_b(const Prm& P, int bh, LAS unsigned char* lds) {
    const int tid = opaque_tid(), lane = tid & 63, r32 = lane & 31, hi = lane >> 5; const int wid = __builtin_amdgcn_readfirstlane(tid >> 6);
    const int b = bh >> 3, h = bh & 7;
    const bf16* Pb = (const bf16*)(P.ws + WS_P) + (size_t)b * LP * NP;
    bf16* mix = (bf16*)(P.ws + WS_MIX);
    const int tm = (wid >> 1) & 1, tn = wid & 1;
    const int tt = tid >> 3, cg = tid & 7, hc = h * 64 + cg * 8;
    for (int i = tid; i < 2 * MB / 4; i += NTHR) ((LAS unsigned*)(lds + PB_S0))[i] = 0u;
    float gw[8], gb[8], muv[8];
    load8(P.gn_w + hc, gw); load8(P.gn_b + hc, gb); load8(P.mu + 1024 + hc, muv);
    const bf16* Abase = (const bf16*)(P.ws + (wid < 4 ? WS_G : WS_Q)) + (size_t)bh * NCHUNK * 4096 + (tm * 32 + r32) * 64 + hi * 8;
    const float* HVbase = (const float*)(P.ws + WS_HV) + (size_t)bh * NCHUNK * 4096 + ((wid & 3) * 64 + lane) * 16;
    const float* BONbase = (const float*)(P.ws + WS_BON) + (size_t)bh * NCHUNK * 64 + tt;
    bf16x8 afA[4], afB[4]; f32x4 ciA[4], ciB[4];
#define PB_LOAD(af_, ci_, ck_) do { const bf16* ag_ = Abase + (size_t)(ck_) * 4096; \
        _Pragma("unroll") for (int ks = 0; ks < 4; ++ks) af_[ks] = *(const bf16x8*)(ag_ + ks * 16); \
        if (wid < 4) { const float* hv_ = HVbase + (size_t)(ck_) * 4096; _Pragma("unroll") for (int g = 0; g < 4; ++g) ci_[g] = *(const f32x4*)(hv_ + 4 * g); } \
        else { _Pragma("unroll") for (int g = 0; g < 4; ++g) ci_[g] = (f32x4){0.f, 0.f, 0.f, 0.f}; } } while (0)
#pragma unroll
    for (int i = 0; i < 8; ++i) asm volatile("" : "+v"(gw[i]), "+v"(gb[i]), "+v"(muv[i]));
    PB_LOAD(afA, ciA, 0); PB_LOAD(afB, ciB, 1);
    u32x4 eyl = {}, evc = {}, evp = {}, ez = {}; float ebon = 0.f;
#define PB_ELOAD(ck_) do { const int t_ = (ck_) * 64 + tt; const bf16* pr_ = Pb + (size_t)t_ * NP; \
        eyl = *(const u32x4*)(mix + ((size_t)b * SEQ + (t_ - 64)) * DM + 512 + hc); evc = *(const u32x4*)(pr_ + PC_RV + hc); evp = *(const u32x4*)(pr_ - NP + PC_RV + hc); \
        ez = *(const u32x4*)(pr_ + PC_ZR + hc); ebon = BONbase[(size_t)(ck_) * 64]; } while (0)
    __syncthreads();
    for (int ck = 0; ck < NCHUNK; ++ck) {
        const int cur = ck & 1;
        const LAS unsigned char* Sb = lds + (cur ? PB_S1 : PB_S0) + (tn * 32 * MS) * 2;
        f32x16 acc;
#pragma unroll
        for (int g = 0; g < 4; ++g) { acc[4 * g] = ciA[g][0]; acc[4 * g + 1] = ciA[g][1]; acc[4 * g + 2] = ciA[g][2]; acc[4 * g + 3] = ciA[g][3]; }
#pragma unroll
        for (int ks = 0; ks < 4; ++ks) { const bf16x8 bfr = *(const LAS bf16x8*)(Sb + (r32 * MS + hi * 8 + ks * 16) * 2);
            acc = __builtin_amdgcn_mfma_f32_32x32x16_bf16(afA[ks], bfr, acc, 0, 0, 0); }
#pragma unroll
        for (int ks = 0; ks < 4; ++ks) { afA[ks] = afB[ks]; ciA[ks] = ciB[ks]; }
        if (ck + 2 < NCHUNK) PB_LOAD(afB, ciB, ck + 2);
        const u32x4 cyl = eyl, cvc = evc, cvp = evp, cz = ez; const float cbon = ebon;
        if (ck + 1 < NCHUNK) PB_ELOAD(ck + 1);
        if (wid < 4) st_tr(lds + (cur ? PB_S0 : PB_S1) + (tn * 32 * MS + tm * 32) * 2, acc, r32, hi);
        else {
#pragma unroll
            for (int r = 0; r < 16; ++r) ((LAS float*)(lds + PB_Y))[(tm * 32 + crow(r, hi)) * 64 + tn * 32 + r32] = acc[r]; }
        BAR_LDS();
        if (ck >= 1) {
            const int t = ck * 64 + tt;
            bf16* mrow = mix + ((size_t)b * SEQ + (t - 64)) * DM + 512 + hc;
            float y8[8], yl8[8], vc[8], vp[8], z8[8];
            lload8((const LAS float*)(lds + PB_Y) + tt * 64 + cg * 8, y8); unpack8(cyl, yl8); unpack8(cvc, vc); unpack8(cvp, vp); unpack8(cz, z8);
            float sm = 0.f;
#pragma unroll
            for (int i = 0; i < 8; ++i) { y8[i] += yl8[i]; sm += y8[i]; }
            const float mean = reduce8(sm) * (1.f / 64.f); float sq = 0.f;
#pragma unroll
            for (int i = 0; i < 8; ++i) { const float d = y8[i] - mean; sq += d * d; }
            const float rstd = __builtin_amdgcn_rsqf(reduce8(sq) * (1.f / 64.f) + GN_EPS);
            float o[8];
#pragma unroll
            for (int i = 0; i < 8; ++i) { const float v = vc[i] + muv[i] * (vp[i] - vc[i]); const float yn = (y8[i] - mean) * rstd * gw[i] + gb[i] + cbon * v; o[i] = yn * z8[i] * sigmoidf_(z8[i]); }
            *(u32x4*)mrow = (u32x4){cvtpk(o[0], o[1]), cvtpk(o[2], o[3]), cvtpk(o[4], o[5]), cvtpk(o[6], o[7])};
        }
        BAR_LDS();
    }
#undef PB_LOAD
#undef PB_ELOAD
    __syncthreads();
}

#define XB_TMO      128
#define XB_XCNT(j)  (256  + 64 * (j))
#define XB_XSUB(j)  (1280 + 64 * (j))
#define XB_XGEN(j)  (2304 + 64 * (j))
#define XB_TOP      3328
#define XB_TOPGEN   3392
#define XCD_BAR_WORDS 3456
#define XB_SPIN_CAP (1u << 18)

__device__ __forceinline__ unsigned xb_ld(unsigned* p)              { return __hip_atomic_load(p, __ATOMIC_RELAXED, __HIP_MEMORY_SCOPE_AGENT); }
__device__ __forceinline__ unsigned xb_add(unsigned* p, unsigned v) { return __hip_atomic_fetch_add(p, v, __ATOMIC_RELAXED, __HIP_MEMORY_SCOPE_AGENT); }
__device__ __forceinline__ unsigned xb_xcc_id() { return (unsigned)__builtin_amdgcn_s_getreg((3 << 11) | 20) & 0xFu; }
#define XB_SPIN(cond, bar) do { unsigned _sp = 0; while (cond) { __builtin_amdgcn_s_sleep(1); \
    if ((++_sp & 255u) == 0u) { if (xb_ld(&(bar)[XB_TMO])) break; if (_sp > XB_SPIN_CAP) { atomicAdd(&(bar)[XB_TMO], 1u); break; } } } } while (0)

struct XcdBarrier {
    unsigned* bar; unsigned x;
    volatile LAS unsigned* st;
};

__device__ __forceinline__ XcdBarrier xcd_barrier_post(unsigned* bar, volatile LAS unsigned* st) {
    XcdBarrier b; b.bar = bar; b.x = xb_xcc_id(); b.st = st;
    if (threadIdx.x == 0) (void)xb_add(&bar[XB_XCNT(b.x)], 1u);
    return b;
}
__device__ __forceinline__ void xcd_barrier_complete(unsigned* bar, unsigned x, unsigned& nloc, unsigned& nx) {
    const unsigned G = gridDim.x * gridDim.y * gridDim.z;
    unsigned sum, cnt, mine, sp = 0u;
    for (;;) {
        sum = 0u; cnt = 0u; mine = 0u;
#pragma unroll
        for (unsigned j = 0; j < 16; ++j) { const unsigned c = xb_ld(&bar[XB_XCNT(j)]); sum += c; cnt += (c > 0u) ? 1u : 0u; mine = (j == x) ? c : mine; }
        if (sum == G) break;
        __builtin_amdgcn_s_sleep(1);
        if ((++sp & 255u) == 0u) { if (xb_ld(&bar[XB_TMO])) break; if (sp > XB_SPIN_CAP) { atomicAdd(&bar[XB_TMO], 1u); break; } }
    }
    nloc = mine > 0u ? mine : 1u; nx = cnt > 0u ? cnt : 1u;
}

__device__ __forceinline__ void xcd_barrier(const XcdBarrier& b) {
    asm volatile("s_waitcnt vmcnt(0)" ::: "memory");
    __syncthreads();
    if (threadIdx.x == 0) {
        unsigned* bar = b.bar;
        __builtin_amdgcn_s_waitcnt(0);
        unsigned nloc = b.st[0], nx = b.st[1];
        if (nloc == 0u) { xcd_barrier_complete(bar, b.x, nloc, nx); b.st[0] = nloc; b.st[1] = nx; }
        const unsigned old = xb_add(&bar[XB_XSUB(b.x)], 1u);
        const unsigned gen = old / nloc;
        if (old + 1u == (gen + 1u) * nloc) {
            __builtin_amdgcn_fence(__ATOMIC_RELEASE, "agent");
            asm volatile("s_waitcnt vmcnt(0)" ::: "memory");
            const unsigned og = xb_add(&bar[XB_TOP], 1u);
            const unsigned tg = og / nx;
            if (og + 1u == (tg + 1u) * nx) xb_add(&bar[XB_TOPGEN], 1u);
            else XB_SPIN(xb_ld(&bar[XB_TOPGEN]) == tg, bar);
            __builtin_amdgcn_fence(__ATOMIC_ACQUIRE, "agent");
            xb_add(&bar[XB_XGEN(b.x)], 1u);
            asm volatile("s_waitcnt vmcnt(0)" ::: "memory");
        } else {
            XB_SPIN(xb_ld(&bar[XB_XGEN(b.x)]) == gen, bar);
            __builtin_amdgcn_fence(__ATOMIC_ACQUIRE, "agent");
            asm volatile("s_waitcnt vmcnt(0)" ::: "memory");
        }
    }
    __syncthreads();
}

constexpr size_t WS_BAR = 13 * MiB + 768 * 1024;
constexpr int LDS_BARST = 146944;
__global__ void __launch_bounds__(NTHR, 2) hymba_fwd(Prm P) {
    extern __shared__ __attribute__((aligned(16))) unsigned char lds_raw[];
    LAS unsigned char* lds = (LAS unsigned char*)lds_raw;
    cg::grid_group grid = cg::this_grid();
    const int G = gridDim.x;
    if (threadIdx.x < 2) ((LAS unsigned*)(lds + LDS_BARST))[threadIdx.x] = 0u;
    __syncthreads();
    const XcdBarrier xbar = xcd_barrier_post((unsigned*)(P.ws + WS_BAR), (volatile LAS unsigned*)(lds + LDS_BARST));
    if (P.ws == nullptr) grid.sync();
    p0_prologue(P, lds, G);
    xcd_barrier(xbar);
    for (int j = G - 1 - (int)blockIdx.x; j < 64; j += G) cb_scan(P, j, lds);
    { pg8::Gemm g{(const pg8::bf16_t*)(P.ws + WS_U), (const pg8::bf16_t*)(P.ws + WS_WTIN), MP, NP, DM}; pg8::StaticOrder S; S.init(MP, NP, G, (int)blockIdx.x);
      pg8::EpiBf16 E{(pg8::bf16_t*)(P.ws + WS_P), NP};
      pg8::gemm_phase<pg8::EpiBf16, pg8::StaticOrder, true, true>(lds, g, S, E); }
    xcd_barrier(xbar);
    if (G == 256) { if ((blockIdx.x & 3) == 0) kmax_job(P, (int)(blockIdx.x >> 2), lds); }
    else for (int j = blockIdx.x; j < 64; j += G) kmax_job(P, j, lds);
    { const int NU = NB * 8 * NCHUNK; const int u0 = (int)(((long)blockIdx.x * NU) / G), u1 = (int)(((long)(blockIdx.x + 1) * NU) / G); int cur_head = -1;
      PAPre pf; if (u0 < u1) { const int t_ = opaque_tid(); pa_prefetch(P, u0, pf, t_, t_ & 63, __builtin_amdgcn_readfirstlane(t_ >> 6)); }
      for (int u = u0; u < u1; ++u) rwkv_pass_a(P, u, lds, cur_head, pf, u + 1 < u1 ? u + 1 : -1); }
    xcd_barrier(xbar);
    for (int bh = blockIdx.x; bh < 64; bh += G) rwkv_pass_b(P, bh, lds);
    { unsigned* ctr = (unsigned*)(P.ws + WS_CTR); LAS unsigned* uidx = (LAS unsigned*)(lds + AL_UIDX);
      const unsigned x0 = xb_xcc_id() & 7u;
      for (unsigned k = 0; k < 8u; ++k) {
          const unsigned x = (x0 + k) & 7u;
          for (;;) {
              if (threadIdx.x == 0) *uidx = atomicAdd(ctr + x * 64, 1u);
              __syncthreads();
              const unsigned u = *uidx;
              __syncthreads();
              if (u >= 128u) break;
              attn_unit(P, (int)(x * 8u + (u & 7u)), 15 - (int)(u >> 3), lds);
          }
      } }
    xcd_barrier(xbar);
    { pg8::Gemm g{(const pg8::bf16_t*)(P.ws + WS_MIX), (const pg8::bf16_t*)(P.ws + WS_WTOUT), MR, DM, DM}; pg8::StaticOrder S; S.init(MR, DM, G, (int)blockIdx.x);
      pg8::EpiResNorm E{P.x, P.out, (float*)(P.ws + WS_ROWSS), (unsigned*)(P.ws + WS_PCNT), P.fnw, DM};
      pg8::gemm_phase<pg8::EpiResNorm, pg8::StaticOrder, true, true>(lds, g, S, E); }
}

extern "C" void kernel_launch(void* const* d_in, const int* in_sizes, int n_in, void* d_out, int out_size, void* d_ws, size_t ws_size, hipStream_t stream) {
    static int grid_blocks = 0;
    if (!grid_blocks) {
        int dev = 0, cus = 0, per_cu = 0;
        (void)hipGetDevice(&dev);
        (void)hipDeviceGetAttribute(&cus, hipDeviceAttributeMultiprocessorCount, dev);
        (void)hipFuncSetAttribute((const void*)hymba_fwd, hipFuncAttributeMaxDynamicSharedMemorySize, LDS_BYTES);
        (void)hipOccupancyMaxActiveBlocksPerMultiprocessor(&per_cu, (const void*)hymba_fwd, NTHR, LDS_BYTES);
        if (per_cu < 1) { fprintf(stderr, "kernel_launch: occupancy query returned %d\n", per_cu); per_cu = 1; }
        grid_blocks = cus * 1;
        (void)hipGetLastError();
    }
    Prm p{};
    p.x = (const float*)d_in[0]; p.meta = (const float*)d_in[1]; p.norm_w = (const float*)d_in[2]; p.w_in = (const float*)d_in[3]; p.b_f = (const float*)d_in[4];
    p.mu = (const float*)d_in[5]; p.w0 = (const float*)d_in[6]; p.w_up = (const float*)d_in[7]; p.a0 = (const float*)d_in[8]; p.a_up = (const float*)d_in[9];
    p.k_k = (const float*)d_in[10]; p.k_a = (const float*)d_in[11]; p.r_k = (const float*)d_in[12]; p.gn_w = (const float*)d_in[13]; p.gn_b = (const float*)d_in[14];
    p.w_out = (const float*)d_in[15]; p.fnw = (const float*)d_in[16];
    p.out = (float*)d_out; p.ws = (unsigned char*)d_ws;
    (void)hipMemsetAsync((unsigned char*)d_ws + WS_BAR, 0, XCD_BAR_WORDS * 4, stream);
    void* args[] = {&p};
    hipError_t e = hipLaunchCooperativeKernel((const void*)hymba_fwd, dim3(grid_blocks), dim3(NTHR), args, LDS_BYTES, stream);
    if (e != hipSuccess) fprintf(stderr, "cooperative launch failed: %s (grid %d)\n", hipGetErrorString(e), grid_blocks);
}
```
